# Optimizing an MI355X kernel written in HIP

```python
import math
import jax, jax.numpy as jnp
from jax import lax
import numpy as np

D_MODEL = 1024
BATCH = 8
SEQ = 4096
DEPTH = 2

D_FF = 2816
HEAD_DIM = 64
ROPE_DIM = HEAD_DIM // 4
ROPE_THETA = 500000.0
EPS = 1e-6
Q_BLOCK = 128
DIFF_HEADS = 4
DIFF_V_HEAD = 2 * HEAD_DIM
NSA_HEADS = 8
NSA_GROUPS = 2
NSA_HPG = NSA_HEADS // NSA_GROUPS
CMP_BLOCK = 32
CMP_STRIDE = 16
CMP_HIDDEN = 256
SEL_BLOCK = 64
SEL_TOPK = 8
WINDOW = 512
FORCED_SCORE = 1.0e4
DIFF_QK = DIFF_HEADS * 2 * HEAD_DIM
DIFF_VW = DIFF_HEADS * DIFF_V_HEAD
NSA_QW = NSA_HEADS * HEAD_DIM
NSA_KVW = NSA_GROUPS * HEAD_DIM
NSA_GATEW = 3 * NSA_HEADS
SPLIT_SIZES = (DIFF_QK, DIFF_QK, DIFF_VW, NSA_QW, NSA_KVW, NSA_KVW, NSA_KVW, NSA_KVW, NSA_KVW, NSA_KVW, NSA_GATEW, D_MODEL, D_MODEL)
IN_COLS = sum(SPLIT_SIZES)

kernel_name = "hybrid_diffattn_nsa_macaron"


def rms_norm(x, g=None):
    xf = x.astype(jnp.float32)
    y = xf * lax.rsqrt(jnp.mean(xf * xf, axis=-1, keepdims=True) + EPS)
    if g is not None:
        y = y * g.astype(jnp.float32)
    return y.astype(x.dtype)


def swiglu(x, w_gu, w_down):
    g, u = jnp.split(x @ w_gu, 2, axis=-1)
    return (jax.nn.silu(g) * u) @ w_down


def rope_partial(x, positions):
    half = ROPE_DIM // 2
    inv = ROPE_THETA ** (-2.0 * jnp.arange(half, dtype=jnp.float32) / ROPE_DIM)
    ang = positions.astype(jnp.float32)[..., None] * inv
    cos = jnp.cos(ang)[:, :, None, :]
    sin = jnp.sin(ang)[:, :, None, :]
    xr = x[..., :ROPE_DIM].astype(jnp.float32)
    x1, x2 = xr[..., :half], xr[..., half:]
    rot = jnp.concatenate([x1 * cos - x2 * sin, x2 * cos + x1 * sin], axis=-1).astype(x.dtype)
    return jnp.concatenate([rot, x[..., ROPE_DIM:]], axis=-1)


def masked_softmax(s, mask):
    s = jnp.where(mask, s.astype(jnp.float32), -jnp.inf)
    m = jnp.max(s, axis=-1, keepdims=True)
    m = jnp.where(jnp.isfinite(m), m, 0.0)
    p = jnp.exp(s - m)
    return p / jnp.maximum(jnp.sum(p, axis=-1, keepdims=True), 1e-30)


def diff_attention(q, k, v, lam, lam_init):
    B, T = q.shape[:2]
    nqb = T // Q_BLOCK
    scale = HEAD_DIM ** -0.5
    qb = q.reshape(B, nqb, Q_BLOCK, DIFF_HEADS, 2, HEAD_DIM).transpose(1, 0, 2, 3, 4, 5)
    kpos = jnp.arange(T)

    def block(args):
        qi, i = args
        qpos = i * Q_BLOCK + jnp.arange(Q_BLOCK)
        s = jnp.einsum('bqhmd,bkhmd->bhmqk', qi, k) * scale
        p = masked_softmax(s, kpos[None, :] <= qpos[:, None])
        a = p[:, :, 0] - lam * p[:, :, 1]
        return jnp.einsum('bhqk,bkhe->bqhe', a.astype(v.dtype), v)

    o = lax.map(block, (qb, jnp.arange(nqb)))
    o = o.transpose(1, 0, 2, 3, 4).reshape(B, T, DIFF_HEADS, DIFF_V_HEAD)
    o = rms_norm(o) * (1.0 - lam_init)
    return o.reshape(B, T, DIFF_VW)


def compress(x, pos_emb, w1, w2):
    B, T, G, dh = x.shape
    n_cmp = (T - CMP_BLOCK) // CMP_STRIDE + 1
    idx = jnp.arange(n_cmp)[:, None] * CMP_STRIDE + jnp.arange(CMP_BLOCK)[None, :]
    blocks = x[:, idx] + pos_emb[None, None, :, None, :]
    flat = blocks.transpose(0, 1, 3, 2, 4).reshape(B, n_cmp, G, CMP_BLOCK * dh)
    return jax.nn.silu(flat @ w1) @ w2


def nsa_attention(q, kc, vc, ks, vs, kw, vw, gates):
    B, T = q.shape[:2]
    G, Hg, dh = NSA_GROUPS, NSA_HPG, HEAD_DIM
    nqb = T // Q_BLOCK
    scale = dh ** -0.5
    n_cmp = kc.shape[1]
    n_sel = T // SEL_BLOCK
    topk = min(SEL_TOPK, n_sel)
    cmp_start = jnp.arange(n_cmp) * CMP_STRIDE
    cmp_end = cmp_start + CMP_BLOCK - 1
    sel_start = jnp.arange(n_sel) * SEL_BLOCK
    ov = jnp.clip(jnp.minimum(cmp_start[:, None] + CMP_BLOCK, sel_start[None, :] + SEL_BLOCK)
                  - jnp.maximum(cmp_start[:, None], sel_start[None, :]), 0)
    overlap = ov.astype(jnp.float32) / CMP_BLOCK
    ksb = ks.reshape(B, n_sel, SEL_BLOCK, G, dh).transpose(0, 3, 1, 2, 4)
    vsb = vs.reshape(B, n_sel, SEL_BLOCK, G, dh).transpose(0, 3, 1, 2, 4)
    pad = ((0, 0), (WINDOW, 0), (0, 0), (0, 0))
    kw_pad = jnp.pad(kw, pad)
    vw_pad = jnp.pad(vw, pad)
    qb = q.reshape(B, nqb, Q_BLOCK, G, Hg, dh).transpose(1, 0, 2, 3, 4, 5)
    gb = gates.reshape(B, nqb, Q_BLOCK, G, Hg, 3).transpose(1, 0, 2, 3, 4, 5)
    bidx = jnp.arange(B)[:, None, None, None]
    gidx = jnp.arange(G)[None, None, :, None]
    jsel = jnp.arange(n_sel)

    def block(args):
        qi, gi, i = args
        qpos = i * Q_BLOCK + jnp.arange(Q_BLOCK)
        s_c = jnp.einsum('bqghd,bcgd->bqghc', qi, kc) * scale
        m_c = (cmp_end[None, :] <= qpos[:, None])[None, :, None, None, :]
        p_c = masked_softmax(s_c, m_c)
        o_c = jnp.einsum('bqghc,bcgd->bqghd', p_c.astype(vc.dtype), vc)
        imp = jnp.einsum('bqghc,cj->bqgj', p_c, overlap)
        cur = qpos // SEL_BLOCK
        forced = (jsel[None, :] == 0) | (jsel[None, :] == cur[:, None]) | (jsel[None, :] == cur[:, None] - 1)
        future = sel_start[None, :] > qpos[:, None]
        imp = jnp.where(future[None, :, None, :], -1.0, jnp.where(forced[None, :, None, :], FORCED_SCORE, imp))
        _, sel = lax.top_k(imp, topk)
        kg = ksb[bidx, gidx, sel].reshape(B, Q_BLOCK, G, topk * SEL_BLOCK, dh)
        vg = vsb[bidx, gidx, sel].reshape(B, Q_BLOCK, G, topk * SEL_BLOCK, dh)
        tok = (sel[..., None] * SEL_BLOCK + jnp.arange(SEL_BLOCK)).reshape(B, Q_BLOCK, G, topk * SEL_BLOCK)
        m_s = (tok <= qpos[None, :, None, None])[:, :, :, None, :]
        s_s = jnp.einsum('bqghd,bqgkd->bqghk', qi, kg) * scale
        p_s = masked_softmax(s_s, m_s)
        o_s = jnp.einsum('bqghk,bqgkd->bqghd', p_s.astype(vg.dtype), vg)
        kwi = lax.dynamic_slice_in_dim(kw_pad, i * Q_BLOCK, WINDOW + Q_BLOCK, axis=1)
        vwi = lax.dynamic_slice_in_dim(vw_pad, i * Q_BLOCK, WINDOW + Q_BLOCK, axis=1)
        kpos = i * Q_BLOCK - WINDOW + jnp.arange(WINDOW + Q_BLOCK)
        m_w = ((kpos[None, :] <= qpos[:, None]) & (kpos[None, :] > qpos[:, None] - WINDOW)
               & (kpos[None, :] >= 0))[None, :, None, None, :]
        s_w = jnp.einsum('bqghd,bkgd->bqghk', qi, kwi) * scale
        p_w = masked_softmax(s_w, m_w)
        o_w = jnp.einsum('bqghk,bkgd->bqghd', p_w.astype(vwi.dtype), vwi)
        return gi[..., 0:1] * o_c + gi[..., 1:2] * o_s + gi[..., 2:3] * o_w

    o = lax.map(block, (qb, gb, jnp.arange(nqb)))
    return o.transpose(1, 0, 2, 3, 4, 5).reshape(B, T, NSA_QW)


def setup_inputs(seed: int = 0) -> dict:
    key = jax.random.key(seed)
    ks = jax.random.split(key, 24)
    n = lambda k, shape, s: jax.random.normal(k, shape, jnp.float32) * s
    gain = lambda k, shape: 1.0 + 0.02 * jax.random.normal(k, shape, jnp.float32)
    L = DEPTH
    return {
        "x": n(ks[0], (BATCH, SEQ, D_MODEL), 1.0),
        "positions": jnp.broadcast_to(jnp.arange(SEQ, dtype=jnp.int32), (BATCH, SEQ)),
        "ffn1_norm": gain(ks[1], (L, D_MODEL)),
        "ffn1_w_gu": n(ks[2], (L, D_MODEL, 2 * D_FF), D_MODEL ** -0.5),
        "ffn1_w_down": n(ks[3], (L, D_FF, D_MODEL), D_FF ** -0.5),
        "mix_norm": gain(ks[4], (L, D_MODEL)),
        "w_in": n(ks[5], (L, D_MODEL, IN_COLS), D_MODEL ** -0.5),
        "diff_lambda": n(ks[6], (L, 4, HEAD_DIM), 0.1),
        "cmp_pos": n(ks[7], (L, 2, CMP_BLOCK, HEAD_DIM), 0.02),
        "cmp_w1": n(ks[8], (L, 2, CMP_BLOCK * HEAD_DIM, CMP_HIDDEN), (CMP_BLOCK * HEAD_DIM) ** -0.5),
        "cmp_w2": n(ks[9], (L, 2, CMP_HIDDEN, HEAD_DIM), CMP_HIDDEN ** -0.5),
        "w_branch_a": n(ks[10], (L, DIFF_VW, D_MODEL), DIFF_VW ** -0.5),
        "w_branch_b": n(ks[11], (L, NSA_QW, D_MODEL), NSA_QW ** -0.5),
        "w_out": n(ks[12], (L, D_MODEL, D_MODEL), D_MODEL ** -0.5),
        "ffn2_norm": gain(ks[13], (L, D_MODEL)),
        "ffn2_w_gu": n(ks[14], (L, D_MODEL, 2 * D_FF), D_MODEL ** -0.5),
        "ffn2_w_down": n(ks[15], (L, D_FF, D_MODEL), D_FF ** -0.5),
        "final_norm": gain(ks[16], (D_MODEL,)),
    }


def reference(x, positions, ffn1_norm, ffn1_w_gu, ffn1_w_down, mix_norm, w_in, diff_lambda,
              cmp_pos, cmp_w1, cmp_w2, w_branch_a, w_branch_b, w_out,
              ffn2_norm, ffn2_w_gu, ffn2_w_down, final_norm):
    B, T, _ = x.shape
    split_points = np.cumsum(SPLIT_SIZES)[:-1].tolist()
    h = x
    for l in range(DEPTH):
        h = h + 0.5 * swiglu(rms_norm(h, ffn1_norm[l]), ffn1_w_gu[l], ffn1_w_down[l])
        u = rms_norm(h, mix_norm[l])
        (q_d, k_d, v_d, q_n, kc_raw, vc_raw, ks_, vs_, kw_, vw_, g_n, g_a, g_b) = jnp.split(u @ w_in[l], split_points, axis=-1)
        q_d = rope_partial(q_d.reshape(B, T, DIFF_HEADS * 2, HEAD_DIM), positions).reshape(B, T, DIFF_HEADS, 2, HEAD_DIM)
        k_d = rope_partial(k_d.reshape(B, T, DIFF_HEADS * 2, HEAD_DIM), positions).reshape(B, T, DIFF_HEADS, 2, HEAD_DIM)
        v_d = v_d.reshape(B, T, DIFF_HEADS, DIFF_V_HEAD)
        lam_init = 0.8 - 0.6 * math.exp(-0.3 * l)
        lp = diff_lambda[l].astype(jnp.float32)
        lam = jnp.exp(jnp.sum(lp[0] * lp[1])) - jnp.exp(jnp.sum(lp[2] * lp[3])) + lam_init
        o_a = diff_attention(q_d, k_d, v_d, lam, lam_init)
        kv_shape = (B, T, NSA_GROUPS, HEAD_DIM)
        q_n = rope_partial(q_n.reshape(B, T, NSA_HEADS, HEAD_DIM), positions)
        kc = compress(kc_raw.reshape(kv_shape), cmp_pos[l, 0], cmp_w1[l, 0], cmp_w2[l, 0])
        vc = compress(vc_raw.reshape(kv_shape), cmp_pos[l, 1], cmp_w1[l, 1], cmp_w2[l, 1])
        ks_r = rope_partial(ks_.reshape(kv_shape), positions)
        kw_r = rope_partial(kw_.reshape(kv_shape), positions)
        gates = jax.nn.sigmoid(g_n.reshape(B, T, NSA_HEADS, 3))
        o_b = nsa_attention(q_n, kc, vc, ks_r, vs_.reshape(kv_shape), kw_r, vw_.reshape(kv_shape), gates)
        y = jax.nn.sigmoid(g_a) * (o_a @ w_branch_a[l]) + jax.nn.sigmoid(g_b) * (o_b @ w_branch_b[l])
        h = h + y @ w_out[l]
        h = h + 0.5 * swiglu(rms_norm(h, ffn2_norm[l]), ffn2_w_gu[l], ffn2_w_down[l])
    return rms_norm(h, final_norm)
```

```cpp
#include <hip/hip_runtime.h>
#include <hip/hip_cooperative_groups.h>
#include <cstdio>
#include <cstdint>
#include <cmath>
namespace cg = cooperative_groups;
#ifndef MK_MULTI
#define MK_MULTI 0
#endif
__device__ __forceinline__ int opaque_tid() { int t = threadIdx.x; asm volatile("" : "+v"(t)); return t; }
__device__ __forceinline__ float my_shfl_xor(float v, int m) { const int l_ = opaque_tid() & 63; return __int_as_float(__builtin_amdgcn_ds_bpermute((l_ ^ m) << 2, __float_as_int(v))); }
namespace pg8 {
#define PG8_LAS __attribute__((address_space(3)))
typedef unsigned short bf16_t;
typedef short bf16x8 __attribute__((ext_vector_type(8)));
typedef float f32x4 __attribute__((ext_vector_type(4)));
typedef unsigned u32x4 __attribute__((ext_vector_type(4)));
constexpr int BM = 256, BK = 64, HALF = 128, HTB = HALF * BK * 2  , STAGE_BYTES = 8 * HTB, NXCD = 8, WGM = 8;

__host__ __device__ __forceinline__ int lds_byte(int r, int c) { const int st = (r >> 4) * 2 + (c >> 5), rr = r & 15, cc = c & 31, ob = rr * 64 + cc * 2; return st * 1024 + (ob ^ (((ob >> 9) & 1) << 5)); }
__host__ __device__ __forceinline__ void stage_rc(int b, int& R, int& C) { const int st = b / 1024, sb = b % 1024, swz = sb ^ (((sb >> 9) & 1) << 5); R = (st >> 1) * 16 + swz / 64; C = (st & 1) * 32 + (swz % 64) / 2; }
__host__ __device__ __forceinline__ int perm32(int rho) { const int n = rho >> 4, i = rho & 15; return 8 * (i >> 2) + 4 * n + (i & 3); }

struct Unit { int pm, pn, idx; };
struct Gemm { const bf16_t* A; const bf16_t* Bt; int M, N, K, lda, ldb; };

struct StaticOrder {
    int nM, nN, nwg, G, c;
    __host__ __device__ void init(int M, int N, int G_, int c_) { nM = M / BM; nN = N / BM; nwg = nM * nN; G = G_; c = c_; }
    __host__ __device__ bool next(int i, Unit& u) const {
        const long L = (long)i * G + c; if (L >= nwg) return false;
        int wgid = (int)L; { const int q = nwg / NXCD, r = nwg % NXCD, xcd = wgid % NXCD, off = wgid / NXCD; wgid = (xcd < r ? xcd * (q + 1) : r * (q + 1) + (xcd - r) * q) + off; }
        const int nig = WGM * nN, gid = wgid / nig, fm = gid * WGM, gsz = (nM - fm) < WGM ? (nM - fm) : WGM;
        u.pm = fm + ((wgid % nig) % gsz); u.pn = (wgid % nig) / gsz; u.idx = i; return true;
    }
    __device__ __forceinline__ void a_ready(const Unit&) const {}
    __device__ __forceinline__ void done(const Unit&) const {}
};

__device__ __forceinline__ unsigned cvt_pk_bf16(float lo, float hi) { unsigned r; asm volatile("v_cvt_pk_bf16_f32 %0, %1, %2" : "=v"(r) : "v"(lo), "v"(hi)); return r; }
typedef float f32x2 __attribute__((ext_vector_type(2)));
template <class Epi, class Sched, bool ALIGN_EPI = false, bool SP2 = false>
__device__ __forceinline__ void gemm_phase(PG8_LAS unsigned char* lds, const Gemm g, const Sched& S, const Epi& E) {
    const int tid = opaque_tid(), wid = __builtin_amdgcn_readfirstlane(tid >> 6), lane = tid & 63, wr = wid >> 2, wc = wid & 3, fr = lane & 15, fq = lane >> 4;
    const int K = g.K, nt = K / BK;
    unsigned voffA[2], voffB[2];
#pragma unroll
    for (int i = 0; i < 2; ++i) { int R, C; stage_rc(tid * 16 + i * 8192, R, C); const int Rb = Epi::PERM ? ((R & ~31) + perm32(R & 31)) : R;
        voffA[i] = (unsigned)(R * g.lda + C) * 2u; voffB[i] = (unsigned)(Rb * g.ldb + C) * 2u; }
    const size_t kstep = (size_t)(BK * 2);
    const size_t hstepA = (size_t)HALF * g.lda * 2, hstepB = (size_t)HALF * g.ldb * 2;
    const size_t tstepA = 2 * hstepA, tstepB = 2 * hstepB;
    const unsigned ldsw = (unsigned)wid * 1024u;
    const int aoff = lds_byte(wr * 64 + fr, fq * 8), boff = lds_byte(wc * 32 + fr, fq * 8);
#define PG8_SA(b, h) (((b) * 2 + (h)) * HTB)
#define PG8_SB(b, h) ((4 + (b) * 2 + (h)) * HTB)
#define PG8_STAGE(bufoff, gbase, voff) do { _Pragma("unroll") for (int _i = 0; _i < 2; ++_i) \
        __builtin_amdgcn_global_load_lds((const unsigned*)((const char*)(gbase) + (voff)[_i]), (PG8_LAS unsigned*)(lds + (bufoff) + ldsw + _i * 8192), 16, 0, 0); } while (0)
#define PG8_LDA(dst, b, h) do { _Pragma("unroll") for (int m = 0; m < 4; ++m) _Pragma("unroll") for (int k = 0; k < 2; ++k) dst[m][k] = *(const PG8_LAS bf16x8*)(lds + PG8_SA(b, h) + aoff + m * 2048 + k * 1024); } while (0)
#define PG8_LDB(dst, b, h) do { _Pragma("unroll") for (int n = 0; n < 2; ++n) _Pragma("unroll") for (int k = 0; k < 2; ++k) dst[n][k] = *(const PG8_LAS bf16x8*)(lds + PG8_SB(b, h) + boff + n * 2048 + k * 1024); } while (0)
#define PG8_MMA(ai, bj, At, Bt) do { __builtin_amdgcn_s_setprio(1); _Pragma("unroll") for (int m = 0; m < 4; ++m) _Pragma("unroll") for (int n = 0; n < 2; ++n) _Pragma("unroll") for (int k = 0; k < 2; ++k) \
        acc[ai][bj][m][n] = __builtin_amdgcn_mfma_f32_16x16x32_bf16(Bt[n][k], At[m][k], acc[ai][bj][m][n], 0, 0, 0); __builtin_amdgcn_s_setprio(0); } while (0)
#define PG8_WAIT_V(n) asm volatile("s_waitcnt vmcnt(" #n ")" ::: "memory")
#define PG8_WAIT_L(n) asm volatile("s_waitcnt lgkmcnt(" #n ")" ::: "memory")
#define PG8_BAR __builtin_amdgcn_s_barrier()
#define PG8_SCHED __builtin_amdgcn_sched_barrier(0)
    Unit cur, nxt; int ui = 0;
    if (!S.next(0, cur)) return;
    f32x4 acc[2][2][4][2];
#pragma unroll
    for (int a = 0; a < 2; ++a)
#pragma unroll
        for (int b = 0; b < 2; ++b)
#pragma unroll
            for (int m = 0; m < 4; ++m)
#pragma unroll
                for (int n = 0; n < 2; ++n) acc[a][b][m][n] = (f32x4){0.f, 0.f, 0.f, 0.f};
    bf16x8 At[4][2], B0[2][2], B1[2][2];
    const char* cA = (const char*)g.A + (size_t)cur.pm * tstepA; const char* cB = (const char*)g.Bt + (size_t)cur.pn * tstepB;
    S.a_ready(cur);
    if constexpr (SP2) {
        PG8_STAGE(PG8_SB(0, 0), cB, voffB); PG8_STAGE(PG8_SB(0, 1), cB + hstepB, voffB); PG8_STAGE(PG8_SA(0, 0), cA, voffA); PG8_STAGE(PG8_SA(0, 1), cA + hstepA, voffA);
        if (wr == 1) PG8_BAR;
        PG8_WAIT_V(2); PG8_BAR;
        PG8_STAGE(PG8_SB(1, 0), cB + kstep, voffB); PG8_STAGE(PG8_SA(1, 0), cA + kstep, voffA); PG8_STAGE(PG8_SB(1, 1), cB + hstepB + kstep, voffB);
        PG8_WAIT_V(6); PG8_BAR;
    } else {
        PG8_STAGE(PG8_SB(0, 0), cB, voffB); PG8_STAGE(PG8_SA(0, 0), cA, voffA); PG8_STAGE(PG8_SB(0, 1), cB + hstepB, voffB); PG8_STAGE(PG8_SA(0, 1), cA + hstepA, voffA);
        if (wr == 1) PG8_BAR;
        PG8_WAIT_V(4); PG8_BAR;
        PG8_STAGE(PG8_SB(1, 0), cB + kstep, voffB); PG8_STAGE(PG8_SA(1, 0), cA + kstep, voffA); PG8_STAGE(PG8_SB(1, 1), cB + hstepB + kstep, voffB);
        PG8_WAIT_V(6); PG8_BAR;
    }
    for (;;) {
        const bool has_next = S.next(ui + 1, nxt);
        const char* nA = has_next ? (const char*)g.A + (size_t)nxt.pm * tstepA : cA; const char* nB = has_next ? (const char*)g.Bt + (size_t)nxt.pn * tstepB : cB;
        for (int t = 0; t < nt; t += 2) {
            const bool last = (t == nt - 2);
            const char* a1 = cA + (size_t)(t + 1) * kstep;
            const char* a2 = last ? nA : cA + (size_t)(t + 2) * kstep; const char* b2 = last ? nB : cB + (size_t)(t + 2) * kstep;
            const char* a3 = a2 + kstep; const char* b3 = b2 + kstep;
            if (last && has_next) S.a_ready(nxt);
            if constexpr (SP2) {
            PG8_LDB(B0, 0, 0); PG8_LDB(B1, 0, 1); PG8_SCHED; PG8_LDA(At, 0, 0); PG8_STAGE(PG8_SA(1, 1), a1 + hstepA, voffA);
            PG8_WAIT_V(8); PG8_WAIT_L(0); PG8_BAR; PG8_MMA(0, 0, At, B0); PG8_MMA(0, 1, At, B1); PG8_BAR; PG8_SCHED;
            PG8_LDA(At, 0, 1); PG8_STAGE(PG8_SB(0, 0), b2, voffB); PG8_STAGE(PG8_SB(0, 1), b2 + hstepB, voffB); PG8_STAGE(PG8_SA(0, 0), a2, voffA);
            PG8_WAIT_V(8); PG8_WAIT_L(0); PG8_BAR; PG8_MMA(1, 0, At, B0); PG8_MMA(1, 1, At, B1); PG8_BAR; PG8_SCHED;
            PG8_LDB(B0, 1, 0); PG8_LDB(B1, 1, 1); PG8_SCHED; PG8_LDA(At, 1, 0); PG8_STAGE(PG8_SA(0, 1), a2 + hstepA, voffA);
            PG8_WAIT_V(8); PG8_WAIT_L(0); PG8_BAR; PG8_MMA(0, 0, At, B0); PG8_MMA(0, 1, At, B1); PG8_BAR; PG8_SCHED;
            PG8_LDA(At, 1, 1); PG8_STAGE(PG8_SB(1, 0), b3, voffB); PG8_STAGE(PG8_SB(1, 1), b3 + hstepB, voffB); PG8_STAGE(PG8_SA(1, 0), a3, voffA);
            PG8_WAIT_V(8); PG8_WAIT_L(0); PG8_BAR; PG8_MMA(1, 0, At, B0); PG8_MMA(1, 1, At, B1); PG8_BAR; PG8_SCHED;
            } else {
            PG8_LDB(B0, 0, 0); PG8_SCHED; PG8_LDA(At, 0, 0); PG8_STAGE(PG8_SA(1, 1), a1 + hstepA, voffA);
            PG8_WAIT_L(8); PG8_BAR; PG8_WAIT_L(0); PG8_MMA(0, 0, At, B0); PG8_BAR; PG8_SCHED;
            PG8_LDB(B1, 0, 1); PG8_STAGE(PG8_SB(0, 0), b2, voffB);
            PG8_BAR; PG8_WAIT_L(0); PG8_MMA(0, 1, At, B1); PG8_BAR;
            PG8_LDA(At, 0, 1); PG8_STAGE(PG8_SA(0, 0), a2, voffA);
            PG8_BAR; PG8_WAIT_L(0); PG8_MMA(1, 0, At, B0); PG8_BAR; PG8_SCHED;
            PG8_STAGE(PG8_SB(0, 1), b2 + hstepB, voffB);
            PG8_WAIT_V(6); PG8_BAR; PG8_MMA(1, 1, At, B1); PG8_BAR;
            PG8_LDB(B0, 1, 0); PG8_SCHED; PG8_LDA(At, 1, 0); PG8_STAGE(PG8_SA(0, 1), a2 + hstepA, voffA);
            PG8_WAIT_L(8); PG8_BAR; PG8_WAIT_L(0); PG8_MMA(0, 0, At, B0); PG8_BAR; PG8_SCHED;
            PG8_LDB(B1, 1, 1); PG8_STAGE(PG8_SB(1, 0), b3, voffB);
            PG8_BAR; PG8_WAIT_L(0); PG8_MMA(0, 1, At, B1); PG8_BAR;
            PG8_LDA(At, 1, 1); PG8_STAGE(PG8_SA(1, 0), a3, voffA);
            PG8_BAR; PG8_WAIT_L(0); PG8_MMA(1, 0, At, B0); PG8_BAR; PG8_SCHED;
            PG8_STAGE(PG8_SB(1, 1), b3 + hstepB, voffB);
            PG8_WAIT_V(6); PG8_BAR; PG8_MMA(1, 1, At, B1); PG8_BAR;
            }
        }
        if constexpr (ALIGN_EPI) { if (wr == 0) PG8_BAR; }
        if constexpr (!Epi::AFTER_DRAIN) { E(acc, cur, wr, wc, fr, fq); S.done(cur); }
        if (!has_next) break;
#pragma unroll
        for (int a = 0; a < 2; ++a)
#pragma unroll
            for (int b = 0; b < 2; ++b)
#pragma unroll
                for (int m = 0; m < 4; ++m)
#pragma unroll
                    for (int n = 0; n < 2; ++n) acc[a][b][m][n] = (f32x4){0.f, 0.f, 0.f, 0.f};
        cur = nxt; cA = nA; cB = nB; ++ui;
        if constexpr (ALIGN_EPI) { if (wr == 1) PG8_BAR; }
    }
    PG8_WAIT_V(0);
    if constexpr (!ALIGN_EPI) { if (wr == 0) PG8_BAR; }
    PG8_BAR;
    if constexpr (Epi::AFTER_DRAIN) { E.fused(acc, cur, wr, wc, fr, fq, lds, wid, lane); S.done(cur); }
#undef PG8_SA
#undef PG8_SB
#undef PG8_STAGE
#undef PG8_LDA
#undef PG8_LDB
#undef PG8_MMA
#undef PG8_WAIT_V
#undef PG8_WAIT_L
#undef PG8_BAR
#undef PG8_SCHED
}
}

using pg8::bf16_t; using pg8::bf16x8; using pg8::f32x4; using pg8::u32x4;
#define LAS __attribute__((address_space(3)))
typedef float f32x16 __attribute__((ext_vector_type(16)));
typedef float f32x2v __attribute__((ext_vector_type(2)));
typedef __bf16 bf16x2v __attribute__((ext_vector_type(2)));
constexpr int NB = 8, T = 4096, D = 1024, M = NB * T, FF = 2816, NL = 2, NIN = 5120;
constexpr float EPS = 1e-6f;
constexpr float C2 = 0.125f * 1.4426950408889634f;
constexpr size_t MiB = 1u << 20;
constexpr size_t WS_SSQ = 0;
constexpr size_t WS_CBP = 2 * MiB;
constexpr size_t WS_CBIAS = WS_CBP + 128 * 1024;
constexpr size_t WS_BAR = WS_CBP + 256 * 1024;
constexpr size_t WS_W = 3 * MiB, W_LAYER = 50 * MiB;
constexpr size_t WO_GU1 = 0, WO_D1 = WO_GU1 + 5632ull * 1024 * 2, WO_GU2 = WO_D1 + 1024ull * 2816 * 2, WO_D2 = WO_GU2 + 5632ull * 1024 * 2,
                 WO_IN = WO_D2 + 1024ull * 2816 * 2, WO_C1 = WO_IN + 5120ull * 1024 * 2, WO_C2 = WO_C1 + 2ull * 256 * 2048 * 2,
                 WO_A = WO_C2 + 2ull * 64 * 256 * 2, WO_B = WO_A + 1024ull * 512 * 2, WO_O = WO_B + 1024ull * 512 * 2, WO_END = WO_O + 1024ull * 1024 * 2;
static_assert(WO_END <= W_LAYER, "weights per layer");
constexpr size_t WS_ROPE = WS_W + NL * W_LAYER;
constexpr size_t WS_HB = WS_ROPE + 2 * MiB;
constexpr size_t WS_BIG = WS_HB + 64 * MiB;
constexpr size_t WS_ACT = WS_BIG;
constexpr size_t WS_QD = WS_BIG, WS_KD = WS_QD + 32 * MiB, WS_VDT = WS_KD + 32 * MiB, WS_QN = WS_VDT + 32 * MiB, WS_KCR = WS_QN + 32 * MiB,
                 WS_KS = WS_KCR + 17 * MiB, WS_KW = WS_KS + 8 * MiB, WS_VST = WS_KW + 8 * MiB, WS_VWT = WS_VST + 8 * MiB, WS_GA = WS_VWT + 8 * MiB,
                 WS_GB = WS_GA + 64 * MiB, WS_GN = WS_GB + 64 * MiB, WS_KC = WS_GN + 3 * MiB, WS_VCT = WS_KC + MiB / 2, WS_OA = WS_VCT + MiB,
                 WS_END = WS_OA + 32 * MiB;
__device__ __forceinline__ bf16_t* oab_ptr(float* out) { return (bf16_t*)((unsigned char*)out + 64 * MiB); }
constexpr size_t WS_Y = WS_KD;
static_assert(WS_END <= 512 * MiB, "workspace");
static_assert(WS_ACT + (size_t)M * FF * 2 <= WS_END, "ACT overlay");
constexpr int LDS_BYTES = 147456;

__device__ __forceinline__ unsigned cvtpk(float lo, float hi) { f32x2v v = {lo, hi}; bf16x2v b = __builtin_convertvector(v, bf16x2v); return __builtin_bit_cast(unsigned, b); }
__device__ __forceinline__ bf16_t f2bf(float x) { return (bf16_t)(cvtpk(x, 0.f) & 0xffffu); }
__device__ __forceinline__ float bflo(unsigned w) { return __uint_as_float(w << 16); }
__device__ __forceinline__ float bfhi(unsigned w) { return __uint_as_float(w & 0xffff0000u); }
__device__ __forceinline__ float sigm(float x) { return __builtin_amdgcn_rcpf(1.f + __expf(-x)); }
__device__ __forceinline__ float silu(float x) { return x * sigm(x); }
__device__ __forceinline__ float rowscale(const float* ssqp, int row) {
    const f32x4* p = (const f32x4*)(ssqp + (size_t)row * 16); const f32x4 a = p[0], b = p[1], c = p[2], d = p[3];
    const float s = (((a[0] + a[1]) + (a[2] + a[3])) + ((b[0] + b[1]) + (b[2] + b[3]))) + (((c[0] + c[1]) + (c[2] + c[3])) + ((d[0] + d[1]) + (d[2] + d[3])));
    return rsqrtf(s * (1.f / 1024.f) + EPS);
}
__device__ __forceinline__ int swap23(int t) { return (t & ~12) | ((t & 4) << 1) | ((t & 8) >> 1); }
__device__ __forceinline__ u32x4 pack8(const float (&v)[8]) { u32x4 w; w.x = cvtpk(v[0], v[1]); w.y = cvtpk(v[2], v[3]); w.z = cvtpk(v[4], v[5]); w.w = cvtpk(v[6], v[7]); return w; }

constexpr int RS_OFF = 131072, RS_MAXU = 15;
template <class Sched> __device__ __forceinline__ void fill_rs(LAS unsigned char* lds, const Sched& S, const float* ssq) {
    const int tid = opaque_tid(); LAS float* tab = (LAS float*)(lds + RS_OFF); pg8::Unit u;
    for (int i = 0; i < RS_MAXU && S.next(i, u); ++i) if (tid < 256) tab[i * 256 + tid] = rowscale(ssq, u.pm * 256 + tid);
    __syncthreads();
}
__device__ __forceinline__ float rs_get(const LAS float* tab, const float* ssq, const pg8::Unit& u, int row) { return u.idx < RS_MAXU ? tab[u.idx * 256 + (row & 255)] : rowscale(ssq, row); }
struct EpiGU {
    static constexpr bool PERM = true, AFTER_DRAIN = false;
    bf16_t* ACT; const float* ssq; const LAS float* rst;
    __device__ __forceinline__ void operator()(const f32x4 (&acc)[2][2][4][2], const pg8::Unit& u, int wr, int wc, int fr, int fq) const {
        const int row0 = u.pm * 256 + wr * 64 + fr, col0 = u.pn * 128 + wc * 32 + fq * 8;
#pragma unroll
        for (int ai = 0; ai < 2; ++ai)
#pragma unroll
            for (int m = 0; m < 4; ++m) {
                const int row = row0 + ai * 128 + m * 16; const float rs = rs_get(rst, ssq, u, row);
                float v[8];
#pragma unroll
                for (int n = 0; n < 2; ++n)
#pragma unroll
                    for (int e = 0; e < 4; ++e) { const float g = acc[ai][0][m][n][e] * rs, uu = acc[ai][1][m][n][e] * rs; v[n * 4 + e] = silu(g) * uu; }
                __builtin_nontemporal_store(pack8(v), (u32x4*)(ACT + (size_t)row * FF + col0));
            }
    }
};
struct EpiRes {
    static constexpr bool PERM = true, AFTER_DRAIN = false;
    const float* Xin; bf16_t* HB; float* ssq_out; float f;
    __device__ __forceinline__ void operator()(const f32x4 (&acc)[2][2][4][2], const pg8::Unit& u, int wr, int wc, int fr, int fq) const {
        const int row0 = u.pm * 256 + wr * 64 + fr, col0 = u.pn * 256 + wc * 32 + fq * 8;
        u32x4 raw[2][4][2];
#pragma unroll
        for (int ai = 0; ai < 2; ++ai)
#pragma unroll
            for (int m = 0; m < 4; ++m)
#pragma unroll
                for (int bj = 0; bj < 2; ++bj) raw[ai][m][bj] = *(const u32x4*)((const char*)HB + (unsigned)(((row0 + ai * 128 + m * 16) * D + col0 + bj * 128) * 2));
        asm volatile("" ::: "memory");
#pragma unroll
        for (int ai = 0; ai < 2; ++ai)
#pragma unroll
            for (int m = 0; m < 4; ++m) {
                const int row = row0 + ai * 128 + m * 16; float ss = 0.f;
#pragma unroll
                for (int bj = 0; bj < 2; ++bj) {
                    const u32x4 q = raw[ai][m][bj];
                    const f32x4 h0 = (f32x4){bflo(q.x), bfhi(q.x), bflo(q.y), bfhi(q.y)} + acc[ai][bj][m][0] * f, h1 = (f32x4){bflo(q.z), bfhi(q.z), bflo(q.w), bfhi(q.w)} + acc[ai][bj][m][1] * f;
                    u32x4 w; w.x = cvtpk(h0[0], h0[1]); w.y = cvtpk(h0[2], h0[3]); w.z = cvtpk(h1[0], h1[1]); w.w = cvtpk(h1[2], h1[3]);
                    *(u32x4*)((char*)HB + (unsigned)((row * D + col0 + bj * 128) * 2)) = w;
                    const float r0 = bflo(w.x), r1 = bfhi(w.x), r2 = bflo(w.y), r3 = bfhi(w.y), r4 = bflo(w.z), r5 = bfhi(w.z), r6 = bflo(w.w), r7 = bfhi(w.w);
                    ss += (r0 * r0 + r1 * r1) + (r2 * r2 + r3 * r3) + (r4 * r4 + r5 * r5) + (r6 * r6 + r7 * r7);
                }
                ss += my_shfl_xor(ss, 16); ss += my_shfl_xor(ss, 32);
                if (fq == 0) ssq_out[(unsigned)(row * 16 + u.pn * 4 + wc)] = ss;
            }
    }
};
struct EpiBrA {
    static constexpr bool PERM = true, AFTER_DRAIN = false;
    bf16_t* Y; const bf16_t* G;
    __device__ __forceinline__ void operator()(const f32x4 (&acc)[2][2][4][2], const pg8::Unit& u, int wr, int wc, int fr, int fq) const {
        const int row0 = u.pm * 256 + wr * 64 + fr, col0 = u.pn * 256 + wc * 32 + fq * 8;
        u32x4 g[2][4][2];
#pragma unroll
        for (int ai = 0; ai < 2; ++ai)
#pragma unroll
            for (int m = 0; m < 4; ++m)
#pragma unroll
                for (int bj = 0; bj < 2; ++bj) g[ai][m][bj] = *(const u32x4*)(G + (size_t)(row0 + ai * 128 + m * 16) * D + col0 + bj * 128);
        asm volatile("" ::: "memory");
#pragma unroll
        for (int ai = 0; ai < 2; ++ai)
#pragma unroll
            for (int m = 0; m < 4; ++m)
#pragma unroll
                for (int bj = 0; bj < 2; ++bj) {
                    const size_t off = (size_t)(row0 + ai * 128 + m * 16) * D + col0 + bj * 128; float v[8];
#pragma unroll
                    for (int k = 0; k < 4; ++k) { v[2 * k] = bflo(g[ai][m][bj][k]) * acc[ai][bj][m][k >> 1][(2 * k) & 3]; v[2 * k + 1] = bfhi(g[ai][m][bj][k]) * acc[ai][bj][m][k >> 1][(2 * k + 1) & 3]; }
                    *(u32x4*)(Y + off) = pack8(v);
                }
    }
};
struct EpiBrB {
    static constexpr bool PERM = true, AFTER_DRAIN = false;
    bf16_t* Y; const bf16_t* G;
    __device__ __forceinline__ void operator()(const f32x4 (&acc)[2][2][4][2], const pg8::Unit& u, int wr, int wc, int fr, int fq) const {
        const int row0 = u.pm * 256 + wr * 64 + fr, col0 = u.pn * 256 + wc * 32 + fq * 8;
#pragma unroll
        for (int ai = 0; ai < 2; ++ai) {
            u32x4 g[4][2], y[4][2];
#pragma unroll
            for (int m = 0; m < 4; ++m)
#pragma unroll
                for (int bj = 0; bj < 2; ++bj) { const size_t off = (size_t)(row0 + ai * 128 + m * 16) * D + col0 + bj * 128; g[m][bj] = *(const u32x4*)(G + off); y[m][bj] = *(const u32x4*)(Y + off); }
            asm volatile("" ::: "memory");
#pragma unroll
            for (int m = 0; m < 4; ++m)
#pragma unroll
                for (int bj = 0; bj < 2; ++bj) {
                    const size_t off = (size_t)(row0 + ai * 128 + m * 16) * D + col0 + bj * 128; float v[8];
#pragma unroll
                    for (int k = 0; k < 4; ++k) { v[2 * k] = bflo(y[m][bj][k]) + bflo(g[m][bj][k]) * acc[ai][bj][m][k >> 1][(2 * k) & 3]; v[2 * k + 1] = bfhi(y[m][bj][k]) + bfhi(g[m][bj][k]) * acc[ai][bj][m][k >> 1][(2 * k + 1) & 3]; }
                    *(u32x4*)(Y + off) = pack8(v);
                }
            asm volatile("" ::: "memory");
        }
    }
};
struct BrOrder {
    pg8::StaticOrder S0;
    __device__ __forceinline__ bool next(int i, pg8::Unit& u) const { pg8::Unit v; if (!S0.next(i >> 1, v)) return false; u.pm = v.pm + (i & 1) * (M / 256); u.pn = v.pn + (i & 1) * (D / 256); u.idx = i; return true; }
    __device__ __forceinline__ void a_ready(const pg8::Unit&) const {}
    __device__ __forceinline__ void done(const pg8::Unit&) const {}
};
struct EpiBr {
    static constexpr bool PERM = true, AFTER_DRAIN = false;
    EpiBrA ea; EpiBrB eb;
    __device__ __forceinline__ void operator()(const f32x4 (&acc)[2][2][4][2], const pg8::Unit& u, int wr, int wc, int fr, int fq) const {
        if (u.pm < M / 256) ea(acc, u, wr, wc, fr, fq);
        else { pg8::Unit v; v.pm = u.pm - M / 256; v.pn = u.pn - D / 256; v.idx = u.idx; eb(acc, v, wr, wc, fr, fq); }
    }
};
struct EpiIn {
    static constexpr bool PERM = true, AFTER_DRAIN = false;
    const float* ssq; const float* rope; unsigned char* ws; const LAS float* rst;
    __device__ __forceinline__ void chunk(int pn, int colt, int row, float (&v)[8], int fq, const f32x4& c, const f32x4& s) const {
        const int b = row >> 12, t = row & (T - 1);
        if (pn < 8) {
            const int buf = pn >> 1, col = (pn & 1) * 256 + colt;
            if (buf == 2) {
                bf16_t* p = (bf16_t*)(ws + WS_VDT) + ((size_t)(b * 4 + (col >> 7)) * 128 + (col & 127)) * T + swap23(t);
#pragma unroll
                for (int i = 0; i < 8; ++i) p[(size_t)i * T] = f2bf(v[i]);
            } else {
                if ((colt & 63) < 16) {
#pragma unroll
                    for (int k = 0; k < 4; ++k) { const float x1 = v[2 * k], x2 = v[2 * k + 1]; v[2 * k] = x1 * c[k] - x2 * s[k]; v[2 * k + 1] = x2 * c[k] + x1 * s[k]; } }
                if (buf != 1) {
#pragma unroll
                    for (int i = 0; i < 8; ++i) v[i] *= C2; }
                bf16_t* base = (bf16_t*)(ws + (buf == 0 ? WS_QD : buf == 1 ? WS_KD : WS_QN));
                __builtin_nontemporal_store(pack8(v), (u32x4*)(base + (size_t)row * 512 + col));
            }
        } else if (pn == 8) {
            const int kv = colt >> 7, g = (colt >> 6) & 1, d = colt & 63;
            *(u32x4*)((bf16_t*)(ws + WS_KCR) + ((size_t)((kv * NB + b) * 2 + g) * T + t) * 64 + d) = pack8(v);
        } else if (pn < 11) {
            if (colt < 128) {
                if ((colt & 63) < 16) {
#pragma unroll
                    for (int k = 0; k < 4; ++k) { const float x1 = v[2 * k], x2 = v[2 * k + 1]; v[2 * k] = x1 * c[k] - x2 * s[k]; v[2 * k + 1] = x2 * c[k] + x1 * s[k]; } }
                *(u32x4*)((bf16_t*)(ws + (pn == 9 ? WS_KS : WS_KW)) + (size_t)row * 128 + colt) = pack8(v);
            } else {
                const int g = (colt - 128) >> 6, d = colt & 63;
                bf16_t* p = (bf16_t*)(ws + (pn == 9 ? WS_VST : WS_VWT)) + ((size_t)(b * 2 + g) * 64 + d) * T + swap23(t);
#pragma unroll
                for (int i = 0; i < 8; ++i) p[(size_t)i * T] = f2bf(v[i]);
            }
        } else if (pn < 19) {
#pragma unroll
            for (int i = 0; i < 8; ++i) v[i] = sigm(v[i]);
            bf16_t* base = (bf16_t*)(ws + (pn < 15 ? WS_GA : WS_GB));
            __builtin_nontemporal_store(pack8(v), (u32x4*)(base + (size_t)row * D + ((pn - 11) & 3) * 256 + colt));
        } else {
            if (colt < 24) { float* p = (float*)(ws + WS_GN) + (size_t)row * 24 + colt;
#pragma unroll
                for (int i = 0; i < 8; ++i) p[i] = sigm(v[i]); }
        }
    }
    __device__ __forceinline__ void operator()(const f32x4 (&acc)[2][2][4][2], const pg8::Unit& u, int wr, int wc, int fr, int fq) const {
        const int row0 = u.pm * 256 + wr * 64 + fr; const int pn = u.pn;
        const bool ropetile = (pn < 4) || pn == 6 || pn == 7 || pn == 9 || pn == 10;
#pragma unroll
        for (int ai = 0; ai < 2; ++ai) {
            f32x4 rc[4], rsn[4];
#pragma unroll
            for (int m = 0; m < 4; ++m) {
                if (ropetile) { const float* rp = rope + (size_t)(row0 + ai * 128 + m * 16) * 16 + 4 * (fq & 1); rc[m] = *(const f32x4*)rp; rsn[m] = *(const f32x4*)(rp + 8); }
                else { rc[m] = (f32x4){1.f, 1.f, 1.f, 1.f}; rsn[m] = (f32x4){0.f, 0.f, 0.f, 0.f}; }
            }
#pragma unroll
            for (int m = 0; m < 4; ++m) {
                const int row = row0 + ai * 128 + m * 16; const float rs = rs_get(rst, ssq, u, row);
#pragma unroll
                for (int bj = 0; bj < 2; ++bj) {
                    float v[8];
#pragma unroll
                    for (int n = 0; n < 2; ++n)
#pragma unroll
                        for (int e = 0; e < 4; ++e) v[n * 4 + e] = acc[ai][bj][m][n][e] * rs;
                    chunk(pn, bj * 128 + wc * 32 + fq * 8, row, v, fq, rc[m], rsn[m]);
                }
            }
            asm volatile("" ::: "memory");
        }
    }
};
struct CmpOrder {
    int G, c;
    __device__ __forceinline__ bool next(int i, pg8::Unit& u) const { const int L = i * G + c; if (L >= 32) return false; u.pm = L; u.pn = L >> 4; u.idx = i; return true; }
    __device__ __forceinline__ void a_ready(const pg8::Unit&) const {}
    __device__ __forceinline__ void done(const pg8::Unit&) const {}
};
struct EpiCmp {
    static constexpr bool PERM = false, AFTER_DRAIN = true;
    const float* cbias;
    const bf16_t* W2t;
    bf16_t* KC; bf16_t* VCT;
    __device__ __forceinline__ void fused(f32x4 (&acc)[2][2][4][2], const pg8::Unit& u, int wr, int wc, int fr, int fq, LAS unsigned char* lds, int wid, int lane) const {
        const int kv = u.pn, bg = u.pm & 15;
        const float* bias = cbias + kv * 256;
#pragma unroll
        for (int bj = 0; bj < 2; ++bj)
#pragma unroll
            for (int n = 0; n < 2; ++n) {
                const int c0 = bj * 128 + wc * 32 + n * 16 + fq * 4; const f32x4 bv = *(const f32x4*)(bias + c0);
#pragma unroll
                for (int ai = 0; ai < 2; ++ai)
#pragma unroll
                    for (int m = 0; m < 4; ++m) {
                        const int r = ai * 128 + wr * 64 + m * 16 + fr; const f32x4 x = acc[ai][bj][m][n] + bv;
                        unsigned w0 = cvtpk(silu(x[0]), silu(x[1])), w1 = cvtpk(silu(x[2]), silu(x[3]));
                        LAS unsigned* p = (LAS unsigned*)(lds + r * 528 + c0 * 2); p[0] = w0; p[1] = w1;
                    }
            }
        __syncthreads();
        const int r32 = lane & 31, hi = lane >> 5;
        f32x16 o0 = {}, o1 = {};
        const bf16_t* wp = W2t + (size_t)kv * 64 * 256;
#pragma unroll 4
        for (int ks = 0; ks < 16; ++ks) {
            const bf16x8 a = *(const LAS bf16x8*)(lds + (wid * 32 + r32) * 528 + (ks * 16 + hi * 8) * 2);
            const bf16x8 b0 = *(const bf16x8*)(wp + (size_t)r32 * 256 + ks * 16 + hi * 8), b1 = *(const bf16x8*)(wp + (size_t)(32 + r32) * 256 + ks * 16 + hi * 8);
            o0 = __builtin_amdgcn_mfma_f32_32x32x16_bf16(a, b0, o0, 0, 0, 0); o1 = __builtin_amdgcn_mfma_f32_32x32x16_bf16(a, b1, o1, 0, 0, 0);
        }
#pragma unroll
        for (int r = 0; r < 16; ++r) {
            const int c = wid * 32 + (r & 3) + 8 * (r >> 2) + 4 * hi; const bool pad = (c == 255);
            const float v0 = pad ? 0.f : o0[r], v1 = pad ? 0.f : o1[r];
            if (kv == 0) { bf16_t* p = KC + ((size_t)bg * 256 + c) * 64; p[r32] = f2bf(v0); p[32 + r32] = f2bf(v1); }
            else { bf16_t* p = VCT + (size_t)bg * 128 * 256 + swap23(c); p[(size_t)r32 * 256] = f2bf(v0); p[(size_t)(32 + r32) * 256] = f2bf(v1); }
        }
        __syncthreads();
    }
};

namespace att {
constexpr int KSTRB = 144;
constexpr int KT_BYTES = 64 * KSTRB, VT_BYTES = 128 * KSTRB, BUF_BYTES = KT_BYTES + VT_BYTES;
constexpr int OFF_WSF = 2 * BUF_BYTES;
constexpr int OFF_IMP = OFF_WSF + 8 * 256;
constexpr int IMP_H = 64 * 65;
constexpr int OFF_SEL = OFF_IMP + 4 * IMP_H * 4;
constexpr int LDS_END = OFF_SEL + 64 * 8;
static_assert(LDS_END <= LDS_BYTES - 64 && OFF_IMP + 8 * 32 * 272 <= LDS_BYTES - 64, "attention LDS");
__device__ __forceinline__ int crow(int r, int hi) { return (r & 3) + 8 * (r >> 2) + 4 * hi; }
#define AT_NEG (-INFINITY)
#define AT_SB() __builtin_amdgcn_sched_barrier(0)
__device__ __forceinline__ float max3f(float a, float b, float c) { float r; asm("v_max3_f32 %0, %1, %2, %3" : "=v"(r) : "v"(a), "v"(b), "v"(c)); return r; }
__device__ __forceinline__ float lane32_max(float m) { auto rr = __builtin_amdgcn_permlane32_swap(__float_as_uint(m), __float_as_uint(m), false, false); return fmaxf(__uint_as_float(rr[0]), __uint_as_float(rr[1])); }
__device__ __forceinline__ float lane32_sum(float m) { auto rr = __builtin_amdgcn_permlane32_swap(__float_as_uint(m), __float_as_uint(m), false, false); return __uint_as_float(rr[0]) + __uint_as_float(rr[1]); }

__device__ __forceinline__ void qk_tile(f32x16& s0, f32x16& s1, const LAS unsigned char* Ks, const bf16x8 (&qf)[4], int r32, int hi) {
    const LAS unsigned char* kb = Ks + r32 * KSTRB + hi * 16;
    s0 = (f32x16){}; s1 = (f32x16){};
#pragma unroll
    for (int d0 = 0; d0 < 4; ++d0) {
        const bf16x8 a0 = *(const LAS bf16x8*)(kb + d0 * 32), a1 = *(const LAS bf16x8*)(kb + 32 * KSTRB + d0 * 32);
        s0 = __builtin_amdgcn_mfma_f32_32x32x16_bf16(a0, qf[d0], s0, 0, 0, 0);
        s1 = __builtin_amdgcn_mfma_f32_32x32x16_bf16(a1, qf[d0], s1, 0, 0, 0);
    }
}

template <int NDB, bool SEL>
__device__ __forceinline__ void tile_step(f32x16 (&o)[NDB], float& m_run, float& l_run, const LAS unsigned char* Ks, LAS float* wsf, const bf16x8 (&qf)[4],
    int t, int kv_lo, int kv_hi, int w_lo_min, int w_lo_max, int w_hi_min, int w_hi_max, unsigned long long selbits, int lane, int r32, int hi)
{
        const int kv0 = t * 64;
        bool skip = (kv0 > w_hi_max) || (kv0 + 63 < w_lo_min);
        bool bit = true;
        if (SEL) { bit = ((selbits >> t) & 1ull) != 0ull; if (!__any(bit)) skip = true; }
        if (!skip) {
            const LAS unsigned char* Vs = Ks + KT_BYTES;
            f32x16 s0, s1;
            { const LAS unsigned char* kb = Ks + r32 * KSTRB + hi * 16; bf16x8 kf[8];
#pragma unroll
              for (int d0 = 0; d0 < 4; ++d0) { kf[2 * d0] = *(const LAS bf16x8*)(kb + d0 * 32); kf[2 * d0 + 1] = *(const LAS bf16x8*)(kb + 32 * KSTRB + d0 * 32); }
              AT_SB();
              s0 = __builtin_amdgcn_mfma_f32_32x32x16_bf16(kf[0], qf[0], (f32x16){}, 0, 0, 0); s1 = __builtin_amdgcn_mfma_f32_32x32x16_bf16(kf[1], qf[0], (f32x16){}, 0, 0, 0);
#pragma unroll
              for (int d0 = 1; d0 < 4; ++d0) { s0 = __builtin_amdgcn_mfma_f32_32x32x16_bf16(kf[2 * d0], qf[d0], s0, 0, 0, 0); s1 = __builtin_amdgcn_mfma_f32_32x32x16_bf16(kf[2 * d0 + 1], qf[d0], s1, 0, 0, 0); }
              AT_SB(); }
            const LAS unsigned char* vb0 = Vs + r32 * KSTRB + hi * 16;
            bf16x8 vf[8];
#pragma unroll
            for (int i = 0; i < 8; ++i) vf[i] = *(const LAS bf16x8*)(vb0 + (i >> 2) * 32 * KSTRB + (i & 3) * 32);
            AT_SB();
            const bool full = (kv0 + 63 <= w_hi_min) && (kv0 >= w_lo_max);
            if (!full) {
#pragma unroll
                for (int r = 0; r < 16; ++r) { const int kv = kv0 + crow(r, hi); if (kv < kv_lo || kv > kv_hi) s0[r] = AT_NEG; if (kv + 32 < kv_lo || kv + 32 > kv_hi) s1[r] = AT_NEG; }
            }
            float mt = fmaxf(s0[0], s1[0]);
#pragma unroll
            for (int r = 1; r < 16; ++r) mt = fmaxf(mt, fmaxf(s0[r], s1[r]));
            if (SEL) mt = bit ? mt : AT_NEG;
            mt = lane32_max(mt);
            if (__any(mt > m_run + 8.f)) {
                const float m_new = fmaxf(m_run, mt);
                const float alpha = (m_new == AT_NEG) ? 1.f : __builtin_amdgcn_exp2f(m_run - m_new);
                l_run *= alpha; m_run = m_new;
                if (hi == 0) wsf[r32] = alpha;
#pragma unroll
                for (int r = 0; r < 16; ++r) { const float a = wsf[crow(r, hi)];
#pragma unroll
                    for (int db = 0; db < NDB; ++db) o[db][r] *= a; }
            }
            float mu = (m_run == AT_NEG) ? 0.f : m_run;
            if (SEL) mu = bit ? mu : INFINITY;
            float ps = 0.f;
#pragma unroll
            for (int r = 0; r < 16; ++r) { s0[r] = __builtin_amdgcn_exp2f(s0[r] - mu); s1[r] = __builtin_amdgcn_exp2f(s1[r] - mu); ps += s0[r] + s1[r]; }
            l_run += ps;
            u32x4 pa[4];
#pragma unroll
            for (int hf = 0; hf < 2; ++hf)
#pragma unroll
                for (int k = 0; k < 4; ++k) { pa[hf][k] = cvtpk(s0[8 * hf + 2 * k], s0[8 * hf + 2 * k + 1]); pa[2 + hf][k] = cvtpk(s1[8 * hf + 2 * k], s1[8 * hf + 2 * k + 1]); }
            AT_SB();
            if (NDB == 2) {
#pragma unroll
                for (int i = 0; i < 8; ++i) o[i >> 2] = __builtin_amdgcn_mfma_f32_32x32x16_bf16(__builtin_bit_cast(bf16x8, pa[i & 3]), vf[i], o[i >> 2], 0, 0, 0);
            } else {
                bf16x8 vg[8];
#pragma unroll
                for (int i = 0; i < 8; ++i) {
                    o[i >> 2] = __builtin_amdgcn_mfma_f32_32x32x16_bf16(__builtin_bit_cast(bf16x8, pa[i & 3]), vf[i], o[i >> 2], 0, 0, 0);
                    vg[i] = *(const LAS bf16x8*)(vb0 + (2 + (i >> 2)) * 32 * KSTRB + (i & 3) * 32);
                }
                AT_SB();
#pragma unroll
                for (int i = 0; i < 8; ++i) o[(NDB == 4 ? 2 : 0) + (i >> 2)] = __builtin_amdgcn_mfma_f32_32x32x16_bf16(__builtin_bit_cast(bf16x8, pa[i & 3]), vg[i], o[(NDB == 4 ? 2 : 0) + (i >> 2)], 0, 0, 0);
            }
            AT_SB();
        }
}

template <int NDB, bool SEL, bool ACC, bool IMP = false>
__device__ __forceinline__ void attn_pass(f32x16 (&oacc)[NDB], LAS unsigned char* shm, const bf16x8 (&qf)[4],
    const bf16_t* __restrict__ Kg, int kpitch, const bf16_t* __restrict__ VTg, int vpitch, int t0, int t1,
    int kv_lo, int kv_hi, int w_lo_min, int w_lo_max, int w_hi_min, int w_hi_max, unsigned long long selbits, float post, float& m_fin, float& il_fin)
{
    const int tid = opaque_tid(), lane = tid & 63, wid = tid >> 6, r32 = lane & 31, hi = lane >> 5;
    const int srow = tid >> 3, sch = tid & 7;
    LAS float* wsf = (LAS float*)(shm + OFF_WSF + wid * 256);
    f32x16 o[NDB];
#pragma unroll
    for (int db = 0; db < NDB; ++db) o[db] = (f32x16){};
    float m_run = AT_NEG, l_run = 0.f;
    u32x4 kA, vA[NDB / 2], kB, vB[NDB / 2];
    const bf16_t* kgp = Kg + (size_t)srow * kpitch + sch * 8; const bf16_t* vgp = VTg + (size_t)srow * vpitch + sch * 8;
#define AT_GLOAD(t, KR, VR) do { const int kv0_ = (t) * 64; KR = *(const u32x4*)(kgp + (size_t)kv0_ * kpitch); \
        _Pragma("unroll") for (int i_ = 0; i_ < NDB / 2; ++i_) VR[i_] = *(const u32x4*)(vgp + (size_t)(64 * i_) * vpitch + kv0_); } while (0)
#define AT_SSTORE(buf, KR, VR) do { LAS unsigned char* b_ = shm + (buf) * BUF_BYTES; *(LAS u32x4*)(b_ + srow * KSTRB + sch * 16) = KR; \
        _Pragma("unroll") for (int i_ = 0; i_ < NDB / 2; ++i_) *(LAS u32x4*)(b_ + KT_BYTES + (srow + 64 * i_) * KSTRB + sch * 16) = VR[i_]; } while (0)
    const int n = t1 - t0;
    if (n > 0) {
    AT_GLOAD(t0, kA, vA); AT_GLOAD(t0 + min(1, n - 1), kB, vB); AT_SSTORE(0, kA, vA);
    __syncthreads();
    for (int i = 0; i < n; i += 2) {
        AT_GLOAD(t0 + min(i + 2, n - 1), kA, vA);
        tile_step<NDB, SEL>(o, m_run, l_run, shm, wsf, qf, t0 + i, kv_lo, kv_hi, w_lo_min, w_lo_max, w_hi_min, w_hi_max, selbits, lane, r32, hi);
        AT_SSTORE(1, kB, vB);
        __syncthreads();
        if (i + 1 >= n) break;
        AT_GLOAD(t0 + min(i + 3, n - 1), kB, vB);
        tile_step<NDB, SEL>(o, m_run, l_run, shm + BUF_BYTES, wsf, qf, t0 + i + 1, kv_lo, kv_hi, w_lo_min, w_lo_max, w_hi_min, w_hi_max, selbits, lane, r32, hi);
        AT_SSTORE(0, kA, vA);
        __syncthreads();
    }
    }
#undef AT_GLOAD
#undef AT_SSTORE
    const float l_tot = lane32_sum(l_run);
    const float inv = l_tot > 0.f ? 1.f / l_tot : 0.f;
    m_fin = m_run; il_fin = inv;
    if (hi == 0) { wsf[r32] = inv * post; if (IMP) wsf[32 + r32] = inv; }
#pragma unroll
    for (int r = 0; r < 16; ++r) { const float a = wsf[crow(r, hi)]; const float a2 = IMP ? wsf[32 + crow(r, hi)] : a;
#pragma unroll
        for (int db = 0; db < NDB; ++db) { const float aa = (IMP && db >= 2) ? a2 : a; if (ACC) oacc[db][r] += o[db][r] * aa; else oacc[db][r] = o[db][r] * aa; } }
#pragma unroll
    for (int db = 0; db < NDB; ++db) asm volatile("" : "+v"(oacc[db]));
}

__device__ __forceinline__ void diff_unit(LAS unsigned char* shm, unsigned char* ws, float* scratch, int b, int h, int qb, float lam, float outscale) {
    const int tid = opaque_tid(), lane = tid & 63, wid = tid >> 6, r32 = lane & 31, hi = lane >> 5;
    const int q0 = qb * 256, qw0 = q0 + 32 * wid, qpos = qw0 + r32; const size_t row = (size_t)b * T + qpos;
    const bf16_t* QD = (const bf16_t*)(ws + WS_QD); const bf16_t* KD = (const bf16_t*)(ws + WS_KD); const bf16_t* VDT = (const bf16_t*)(ws + WS_VDT);
    f32x16 oacc[4];
    float mf, ilf;
    f32x4* o0s = (f32x4*)scratch + ((((size_t)b * T + qw0) >> 5) * 4 + h) * 1024 + lane;
    {
        bf16x8 qf[4];
#pragma unroll
        for (int d0 = 0; d0 < 4; ++d0) qf[d0] = *(const bf16x8*)(QD + row * 512 + h * 128 + d0 * 16 + hi * 8);
        attn_pass<4, false, false>(oacc, shm, qf, KD + (size_t)b * T * 512 + h * 128, 512, VDT + (size_t)(b * 4 + h) * 128 * T, T, 0, (q0 + 256) / 64,
                            0, qpos, 0, 0, qw0, qw0 + 31, 0ull, 1.f, mf, ilf);
#pragma unroll
        for (int db = 0; db < 4; ++db)
#pragma unroll
            for (int r4 = 0; r4 < 4; ++r4) o0s[(db * 4 + r4) * 64] = (f32x4){oacc[db][4 * r4], oacc[db][4 * r4 + 1], oacc[db][4 * r4 + 2], oacc[db][4 * r4 + 3]};
    }
    {
        bf16x8 qf[4];
#pragma unroll
        for (int d0 = 0; d0 < 4; ++d0) qf[d0] = *(const bf16x8*)(QD + row * 512 + h * 128 + 64 + d0 * 16 + hi * 8);
        attn_pass<4, false, false>(oacc, shm, qf, KD + (size_t)b * T * 512 + h * 128 + 64, 512, VDT + (size_t)(b * 4 + h) * 128 * T, T, 0, (q0 + 256) / 64,
                            0, qpos, 0, 0, qw0, qw0 + 31, 0ull, -lam, mf, ilf);
#pragma unroll
        for (int db = 0; db < 4; ++db)
#pragma unroll
            for (int r4 = 0; r4 < 4; ++r4) { const f32x4 v = o0s[(db * 4 + r4) * 64];
#pragma unroll
                for (int e = 0; e < 4; ++e) oacc[db][4 * r4 + e] += v[e]; }
    }
    { LAS unsigned char* stg = shm + OFF_IMP + wid * (32 * 272);
#pragma unroll
      for (int r = 0; r < 16; ++r) {
        float ss = 0.f;
#pragma unroll
        for (int db = 0; db < 4; ++db) ss += oacc[db][r] * oacc[db][r];
        ss += __shfl_xor(ss, 1); ss += __shfl_xor(ss, 2); ss += __shfl_xor(ss, 4); ss += __shfl_xor(ss, 8); ss += __shfl_xor(ss, 16);
        const float rn = rsqrtf(ss * (1.f / 128.f) + EPS) * outscale;
#pragma unroll
        for (int db = 0; db < 4; ++db) *(LAS bf16_t*)(stg + crow(r, hi) * 272 + (32 * db + r32) * 2) = f2bf(oacc[db][r] * rn);
      }
      asm volatile("s_waitcnt lgkmcnt(0)" ::: "memory");
      bf16_t* OA = oab_ptr(scratch) + ((size_t)b * T + qw0) * 512 + h * 128;
#pragma unroll
      for (int i = 0; i < 8; ++i) { const int rr = i * 4 + (lane >> 4), ch = lane & 15; const u32x4 v = *(const LAS u32x4*)(stg + rr * 272 + ch * 16); *(u32x4*)(OA + (size_t)rr * 512 + ch * 8) = v; }
    }
    __syncthreads();
}

__device__ __forceinline__ void nsa_unit(LAS unsigned char* shm, unsigned char* ws, float* dout, int b, int g, int cur) {
    const int tid = opaque_tid(), lane = tid & 63, wid = tid >> 6, r32 = lane & 31, hi = lane >> 5;
    const int q0 = cur * 64, head = g * 4 + (wid >> 1), qlw = 32 * (wid & 1), qloc = qlw + r32, qpos = q0 + qloc; const size_t row = (size_t)b * T + qpos;
    const int bg = b * 2 + g;
    LAS float* imp = (LAS float*)(shm + OFF_IMP);
    LAS unsigned long long* selm = (LAS unsigned long long*)(shm + OFF_SEL);
    bf16x8 qf[4];
    { const bf16_t* QN = (const bf16_t*)(ws + WS_QN);
#pragma unroll
      for (int d0 = 0; d0 < 4; ++d0) qf[d0] = *(const bf16x8*)(QN + row * 512 + head * 64 + d0 * 16 + hi * 8); }
    const float* gn = (const float*)(ws + WS_GN) + row * 24 + head * 3;
    f32x16 oacc[2];
    const bf16_t* KC = (const bf16_t*)(ws + WS_KC) + (size_t)bg * 256 * 64; const bf16_t* VCT = (const bf16_t*)(ws + WS_VCT) + (size_t)bg * 128 * 256;
    const int hic = min(254, (qpos - 31) >> 4), hic_min = min(254, (q0 + qlw - 31) >> 4), hic_max = min(254, (q0 + qlw + 31 - 31) >> 4);
    const int ntc = (min(254, (q0 + 63 - 31) >> 4) >> 6) + 1;
    float m_c, il_c;
    { f32x16 tc[4];
      attn_pass<4, false, false, true>(tc, shm, qf, KC, 64, VCT, 256, 0, ntc, 0, hic, 0, 0, hic_min, hic_max, 0ull, gn[0], m_c, il_c);
      oacc[0] = tc[0]; oacc[1] = tc[1];
      LAS float* ih = imp + (wid >> 1) * IMP_H + qlw;
#pragma unroll
      for (int jb = 0; jb < 2; ++jb)
#pragma unroll
          for (int r = 0; r < 16; ++r) ih[(32 * jb + r32) * 65 + crow(r, hi)] = tc[2 + jb][r];
    }
    __syncthreads();
#pragma unroll 1
    for (int qi = 0; qi < 8; ++qi) {
        const int q = wid * 8 + qi, j = lane;
        float v = ((imp[j * 65 + q] + imp[IMP_H + j * 65 + q]) + imp[2 * IMP_H + j * 65 + q]) + imp[3 * IMP_H + j * 65 + q];
        if (j > cur) v = 0.f; else if (j == 0 || j == cur || j == cur - 1) v = 1.0e4f; else v = fmaxf(v, 1e-30f);
        const unsigned key = (__float_as_uint(v) & ~63u) | (unsigned)(63 - j);
        unsigned thr = 0u;
#pragma unroll
        for (int bitp = 30; bitp >= 0; --bitp) { const unsigned cand = thr | (1u << bitp); const int cge = __popcll(__ballot(key >= cand)); thr = (cge >= 8) ? cand : thr; }
        const bool sel = key >= thr;
        const unsigned long long bits = __ballot(sel);
        if (lane == 0) selm[q] = bits;
    }
    __syncthreads();
    const unsigned long long selbits = selm[qloc];
    const bf16_t* KS = (const bf16_t*)(ws + WS_KS) + (size_t)b * T * 128 + g * 64; const bf16_t* VST = (const bf16_t*)(ws + WS_VST) + (size_t)bg * 64 * T;
    float mf, ilf;
    attn_pass<2, true, true>(oacc, shm, qf, KS, 128, VST, T, 0, cur + 1, 0, qpos, 0, 0, q0 + qlw, q0 + qlw + 31, selbits, gn[1], mf, ilf);
    const bf16_t* KW = (const bf16_t*)(ws + WS_KW) + (size_t)b * T * 128 + g * 64; const bf16_t* VWT = (const bf16_t*)(ws + WS_VWT) + (size_t)bg * 64 * T;
    attn_pass<2, false, true>(oacc, shm, qf, KW, 128, VWT, T, max(0, cur - 8), cur + 1, qpos - 511, qpos, q0 + qlw - 511, q0 + qlw + 31 - 511, q0 + qlw, q0 + qlw + 31, 0ull, gn[2], mf, ilf);
    { const int tid2 = opaque_tid(), lane2 = tid2 & 63, wid2 = tid2 >> 6, r32b = lane2 & 31, hib = lane2 >> 5;
      LAS unsigned char* stg = shm + wid2 * (32 * 144);
#pragma unroll
      for (int r = 0; r < 16; ++r) { LAS bf16_t* p = (LAS bf16_t*)(stg + crow(r, hib) * 144 + r32b * 2); p[0] = f2bf(oacc[0][r]); p[32] = f2bf(oacc[1][r]); }
      asm volatile("s_waitcnt lgkmcnt(0)" ::: "memory");
      bf16_t* OB = oab_ptr(dout) + (size_t)M * 512 + ((size_t)b * T + cur * 64 + 32 * (wid2 & 1)) * 512 + (g * 4 + (wid2 >> 1)) * 64;
#pragma unroll
      for (int i = 0; i < 4; ++i) { const int rr = i * 8 + (lane2 >> 3), ch = lane2 & 7; const u32x4 v = *(const LAS u32x4*)(stg + rr * 144 + ch * 16); *(u32x4*)(OB + (size_t)rr * 512 + ch * 8) = v; } }
    __syncthreads();
}
}

struct Params { const float* in[18]; float* out; unsigned char* ws; int ph_lo, ph_hi; };
enum { I_X = 0, I_POS, I_F1N, I_F1GU, I_F1D, I_MIXN, I_WIN, I_LAM, I_CPOS, I_CW1, I_CW2, I_WA, I_WB, I_WO, I_F2N, I_F2GU, I_F2D, I_FINN };

__device__ __forceinline__ int headperm(int p) { return p < 16 ? (p >> 1) + 8 * (p & 1) : p; }
__device__ __forceinline__ int mapcol(int kind, int n) {
    if (kind == 0) return n;
    if (kind == 1) { const int tile = n >> 8, w = n & 255; return w < 128 ? tile * 128 + w : FF + tile * 128 + (w - 128); }
    if (kind == 3) return (n & ~63) + headperm(n & 63);
    if (n < 2816) {
        const bool ropeseg = (n < 1024) || (n >= 1536 && n < 2048) || (n >= 2304 && n < 2432) || (n >= 2560 && n < 2688);
        return ropeseg ? (n & ~63) + headperm(n & 63) : n;
    }
    if (n < 3840) return 2840 + (n - 2816);
    if (n < 4864) return 3864 + (n - 3840);
    if (n < 4888) return 2816 + (n - 4864);
    return -1;
}
__device__ __forceinline__ void transpose_item(const float* __restrict__ W, int K, int N, bf16_t* __restrict__ WT, int nblk, int item, int kind, const float* __restrict__ gain, LAS float* scr, int lane) {
    const int kb = item / nblk, nb = item % nblk, k0 = 64 * kb, n0 = 32 * nb;
    const int lc = mapcol(kind, n0 + (lane & 31));
    float wv[32];
    const float* wp = W + (size_t)(k0 + (lane >> 5)) * N + (lc >= 0 ? lc : 0);
#pragma unroll
    for (int i = 0; i < 32; ++i) wv[i] = wp[(size_t)(2 * i) * N];
#pragma unroll
    for (int i = 0; i < 32; ++i) { const int kk = 2 * i + (lane >> 5); float v = lc >= 0 ? wv[i] : 0.f; if (gain) v *= gain[k0 + kk]; scr[kk * 33 + (lane & 31)] = v; }
    asm volatile("s_waitcnt lgkmcnt(0)" ::: "memory");
    const int c = lane & 7;
#pragma unroll
    for (int j = 0; j < 4; ++j) { const int n = (lane >> 3) + 8 * j; const LAS float* s = scr + (8 * c) * 33 + n;
        u32x4 o; o.x = cvtpk(s[0 * 33], s[1 * 33]); o.y = cvtpk(s[2 * 33], s[3 * 33]); o.z = cvtpk(s[4 * 33], s[5 * 33]); o.w = cvtpk(s[6 * 33], s[7 * 33]);
        *(u32x4*)(WT + (size_t)(n0 + n) * K + k0 + 8 * c) = o; }
    asm volatile("s_waitcnt lgkmcnt(0)" ::: "memory");
}
__device__ __forceinline__ float wave_sum(float v) {
#pragma unroll
    for (int o = 1; o < 64; o <<= 1) v += my_shfl_xor(v, o);
    return v;
}
__device__ __forceinline__ void prep_phase(const Params& P, LAS unsigned char* lds) {
    const int tid = opaque_tid(), lane = tid & 63, wave = tid >> 6;
    const int gw = blockIdx.x * 8 + wave, NGW = gridDim.x * 8;
    LAS float* scr = (LAS float*)(lds + wave * 16384);
    unsigned char* ws = P.ws;
    constexpr int JOBS = 12;
    constexpr int ITEMS[JOBS] = {16 * 176, 44 * 32, 16 * 176, 44 * 32, 16 * 160, 32 * 8, 32 * 8, 4 * 2, 4 * 2, 8 * 32, 8 * 32, 16 * 32};
    constexpr int PER_LAYER = 16 * 176 * 2 + 44 * 32 * 2 + 16 * 160 + 32 * 8 * 2 + 4 * 2 * 2 + 8 * 32 * 2 + 16 * 32;
    for (int it = gw; it < NL * PER_LAYER; it += NGW) {
        const int l = it / PER_LAYER; int r = it % PER_LAYER, job = 0;
#pragma unroll
        for (int jj = 0; jj < JOBS - 1; ++jj) { if (job == jj && r >= ITEMS[jj]) { r -= ITEMS[jj]; job = jj + 1; } }
        unsigned char* wl = ws + WS_W + (size_t)l * W_LAYER;
        const float* src; bf16_t* dst; int K, N, nblk, kind = 0; const float* gain = nullptr;
        switch (job) {
            case 0:  src = P.in[I_F1GU] + (size_t)l * D * 2 * FF; dst = (bf16_t*)(wl + WO_GU1); K = D; N = 2 * FF; nblk = 176; kind = 1; gain = P.in[I_F1N] + l * D; break;
            case 1:  src = P.in[I_F1D] + (size_t)l * FF * D; dst = (bf16_t*)(wl + WO_D1); K = FF; N = D; nblk = 32; break;
            case 2:  src = P.in[I_F2GU] + (size_t)l * D * 2 * FF; dst = (bf16_t*)(wl + WO_GU2); K = D; N = 2 * FF; nblk = 176; kind = 1; gain = P.in[I_F2N] + l * D; break;
            case 3:  src = P.in[I_F2D] + (size_t)l * FF * D; dst = (bf16_t*)(wl + WO_D2); K = FF; N = D; nblk = 32; break;
            case 4:  src = P.in[I_WIN] + (size_t)l * D * 4888; dst = (bf16_t*)(wl + WO_IN); K = D; N = 4888; nblk = 160; kind = 2; gain = P.in[I_MIXN] + l * D; break;
            case 5:  src = P.in[I_CW1] + (size_t)(l * 2 + 0) * 2048 * 256; dst = (bf16_t*)(wl + WO_C1); K = 2048; N = 256; nblk = 8; break;
            case 6:  src = P.in[I_CW1] + (size_t)(l * 2 + 1) * 2048 * 256; dst = (bf16_t*)(wl + WO_C1) + 256 * 2048; K = 2048; N = 256; nblk = 8; break;
            case 7:  src = P.in[I_CW2] + (size_t)(l * 2 + 0) * 256 * 64; dst = (bf16_t*)(wl + WO_C2); K = 256; N = 64; nblk = 2; kind = 3; break;
            case 8:  src = P.in[I_CW2] + (size_t)(l * 2 + 1) * 256 * 64; dst = (bf16_t*)(wl + WO_C2) + 64 * 256; K = 256; N = 64; nblk = 2; break;
            case 9:  src = P.in[I_WA] + (size_t)l * 512 * D; dst = (bf16_t*)(wl + WO_A); K = 512; N = D; nblk = 32; break;
            case 10: src = P.in[I_WB] + (size_t)l * 512 * D; dst = (bf16_t*)(wl + WO_B); K = 512; N = D; nblk = 32; break;
            default: src = P.in[I_WO] + (size_t)l * D * D; dst = (bf16_t*)(wl + WO_O); K = D; N = D; nblk = 32; break;
        }
        transpose_item(src, K, N, dst, nblk, r, kind, gain, scr, lane);
    }
    { const float* x = P.in[I_X]; bf16_t* HB = (bf16_t*)(ws + WS_HB); float* ssq0 = (float*)(ws + WS_SSQ);
      for (int m0 = gw * 2; m0 < M; m0 += NGW * 2) {
        f32x4 v[2][4];
#pragma unroll
        for (int rr = 0; rr < 2; ++rr) { const f32x4* xr = (const f32x4*)(x + (size_t)(m0 + rr) * D) + lane;
#pragma unroll
            for (int j = 0; j < 4; ++j) v[rr][j] = xr[64 * j]; }
#pragma unroll
        for (int rr = 0; rr < 2; ++rr) { const int m = m0 + rr;
            unsigned long long* o8 = (unsigned long long*)(HB + (size_t)m * D) + lane; float s = 0.f;
#pragma unroll
            for (int j = 0; j < 4; ++j) { const f32x4 w = v[rr][j]; s += (w[0] * w[0] + w[1] * w[1]) + (w[2] * w[2] + w[3] * w[3]);
                o8[64 * j] = (unsigned long long)cvtpk(w[0], w[1]) | ((unsigned long long)cvtpk(w[2], w[3]) << 32); }
            s = wave_sum(s); if (lane < 16) ssq0[(size_t)m * 16 + lane] = (lane == 0) ? s : 0.f; }
      } }
    { const int* pos = (const int*)P.in[I_POS]; float* rope = (float*)(ws + WS_ROPE);
      const float inv[8] = {1.0f, 0.1939227432012558f, 0.03760603070259094f, 0.007292664609849453f, 0.0014142135623842478f, 0.00027424818836152554f, 5.318296098266728e-05f, 1.0313386155758053e-05f};
      for (int i = blockIdx.x * 512 + tid; i < M * 8; i += gridDim.x * 512) {
        const int m = i >> 3, d = i & 7; float iv = inv[0];
#pragma unroll
        for (int k = 1; k < 8; ++k) iv = (d == k) ? inv[k] : iv;
        const float ang = (float)pos[m] * iv; float sv, cv; sincosf(ang, &sv, &cv);
        rope[(size_t)m * 16 + d] = cv; rope[(size_t)m * 16 + 8 + d] = sv;
      } }
    { bf16_t* vct = (bf16_t*)(ws + WS_VCT);
      for (int i = blockIdx.x * 512 + tid; i < 16 * 64 * 256; i += gridDim.x * 512) {
        const int c = i & 255, j = (i >> 8) & 63, bgi = i >> 14;
        const float ov = (c >= 4 * j && c <= 4 * j + 2) ? 1.f : ((c == 4 * j + 3 || c == 4 * j - 1) ? 0.5f : 0.f);
        vct[((size_t)bgi * 128 + 64 + j) * 256 + swap23(c)] = f2bf(c == 255 ? 0.f : ov);
      } }
    { float* cb = (float*)(ws + WS_CBP);
      for (int it = gw; it < NL * 2 * 4 * 32; it += NGW) {
        const int kc = it & 31, nbk = (it >> 5) & 3, lk = it >> 7;
        const float* w1 = P.in[I_CW1] + (size_t)lk * 2048 * 256; const float* cp = P.in[I_CPOS] + (size_t)lk * 2048; const int n = nbk * 64 + lane;
        float s = 0.f;
#pragma unroll 8
        for (int k = kc * 64; k < kc * 64 + 64; ++k) s += cp[k] * w1[(size_t)k * 256 + n];
        cb[((size_t)lk * 32 + kc) * 256 + n] = s;
      } }
}
__device__ __forceinline__ void final_phase(const Params& P) {
    const int tid_ = opaque_tid(), lane = tid_ & 63, gw = blockIdx.x * 8 + (tid_ >> 6), NGW = gridDim.x * 8;
    const float* ssq = (const float*)(P.ws + WS_SSQ); const bf16_t* HB = (const bf16_t*)(P.ws + WS_HB);
    const float* gp = P.in[I_FINN] + lane * 8;
    const f32x4 g0 = *(const f32x4*)gp, g1 = *(const f32x4*)(gp + 4), g2 = *(const f32x4*)(gp + 512), g3 = *(const f32x4*)(gp + 516);
    for (int m0 = gw * 4; m0 < M; m0 += NGW * 4) {
        u32x4 v[4][2]; float rs[4];
#pragma unroll
        for (int rr = 0; rr < 4; ++rr) { rs[rr] = rowscale(ssq, m0 + rr); const bf16_t* hr = HB + (size_t)(m0 + rr) * D + lane * 8; v[rr][0] = *(const u32x4*)hr; v[rr][1] = *(const u32x4*)(hr + 512); }
#pragma unroll
        for (int rr = 0; rr < 4; ++rr) { float* o = P.out + (size_t)(m0 + rr) * D + lane * 8; const float r = rs[rr];
            const u32x4 a = v[rr][0], b = v[rr][1];
            *(f32x4*)o = (f32x4){bflo(a.x), bfhi(a.x), bflo(a.y), bfhi(a.y)} * r * g0; *(f32x4*)(o + 4) = (f32x4){bflo(a.z), bfhi(a.z), bflo(a.w), bfhi(a.w)} * r * g1;
            *(f32x4*)(o + 512) = (f32x4){bflo(b.x), bfhi(b.x), bflo(b.y), bfhi(b.y)} * r * g2; *(f32x4*)(o + 516) = (f32x4){bflo(b.z), bfhi(b.z), bflo(b.w), bfhi(b.w)} * r * g3; }
    }
}

#define XB_TMO      128
#define XB_XCNT(j)  (256  + 64 * (j))
#define XB_XSUB(j)  (1280 + 64 * (j))
#define XB_XGEN(j)  (2304 + 64 * (j))
#define XB_TOP      3328
#define XB_TOPGEN   3392
#define XCD_BAR_WORDS 3456
#define XB_SPIN_CAP (1u << 18)

__device__ __forceinline__ unsigned xb_ld(unsigned* p)              { return __hip_atomic_load(p, __ATOMIC_RELAXED, __HIP_MEMORY_SCOPE_AGENT); }
__device__ __forceinline__ unsigned xb_add(unsigned* p, unsigned v) { return __hip_atomic_fetch_add(p, v, __ATOMIC_RELAXED, __HIP_MEMORY_SCOPE_AGENT); }
__device__ __forceinline__ unsigned xb_xcc_id() { return (unsigned)__builtin_amdgcn_s_getreg((3 << 11) | 20) & 0xFu; }
#define XB_SPIN(cond, bar) do { unsigned _sp = 0; while (cond) { __builtin_amdgcn_s_sleep(1); \
    if ((++_sp & 255u) == 0u) { if (xb_ld(&(bar)[XB_TMO])) break; if (_sp > XB_SPIN_CAP) { atomicAdd(&(bar)[XB_TMO], 1u); break; } } } } while (0)

struct XcdBarrier {
    unsigned* bar; unsigned x;
    volatile LAS unsigned* st;
};

__device__ __forceinline__ XcdBarrier xcd_barrier_post(unsigned* bar, volatile LAS unsigned* st) {
    XcdBarrier b; b.bar = bar; b.x = xb_xcc_id(); b.st = st;
    if (threadIdx.x == 0) (void)xb_add(&bar[XB_XCNT(b.x)], 1u);
    return b;
}
__device__ __forceinline__ void xcd_barrier_complete(unsigned* bar, unsigned x, unsigned& nloc, unsigned& nx) {
    const unsigned G = gridDim.x * gridDim.y * gridDim.z;
    unsigned sum, cnt, mine, sp = 0u;
    for (;;) {
        sum = 0u; cnt = 0u; mine = 0u;
#pragma unroll
        for (unsigned j = 0; j < 16; ++j) { const unsigned c = xb_ld(&bar[XB_XCNT(j)]); sum += c; cnt += (c > 0u) ? 1u : 0u; mine = (j == x) ? c : mine; }
        if (sum == G) break;
        __builtin_amdgcn_s_sleep(1);
        if ((++sp & 255u) == 0u) { if (xb_ld(&bar[XB_TMO])) break; if (sp > XB_SPIN_CAP) { atomicAdd(&bar[XB_TMO], 1u); break; } }
    }
    nloc = mine > 0u ? mine : 1u; nx = cnt > 0u ? cnt : 1u;
}

__device__ __forceinline__ void xcd_barrier(const XcdBarrier& b) {
    asm volatile("s_waitcnt vmcnt(0)" ::: "memory");
    __syncthreads();
    if (threadIdx.x == 0) {
        unsigned* bar = b.bar;
        __builtin_amdgcn_s_waitcnt(0);
        unsigned nloc = b.st[0], nx = b.st[1];
        if (nloc == 0u) { xcd_barrier_complete(bar, b.x, nloc, nx); b.st[0] = nloc; b.st[1] = nx; }
        const unsigned old = xb_add(&bar[XB_XSUB(b.x)], 1u);
        const unsigned gen = old / nloc;
        if (old + 1u == (gen + 1u) * nloc) {
            __builtin_amdgcn_fence(__ATOMIC_RELEASE, "agent");
            asm volatile("s_waitcnt vmcnt(0)" ::: "memory");
            const unsigned og = xb_add(&bar[XB_TOP], 1u);
            const unsigned tg = og / nx;
            if (og + 1u == (tg + 1u) * nx) xb_add(&bar[XB_TOPGEN], 1u);
            else XB_SPIN(xb_ld(&bar[XB_TOPGEN]) == tg, bar);
            __builtin_amdgcn_fence(__ATOMIC_ACQUIRE, "agent");
            xb_add(&bar[XB_XGEN(b.x)], 1u);
            asm volatile("s_waitcnt vmcnt(0)" ::: "memory");
        } else {
            XB_SPIN(xb_ld(&bar[XB_XGEN(b.x)]) == gen, bar);
            __builtin_amdgcn_fence(__ATOMIC_ACQUIRE, "agent");
            asm volatile("s_waitcnt vmcnt(0)" ::: "memory");
        }
    }
    __syncthreads();
}

constexpr int N_PHASES = 22;
#ifndef REP_PREP
#define REP_PREP 1
#endif
#ifndef REP_CMP
#define REP_CMP 1
#endif
#ifndef REP_DIFF
#define REP_DIFF 1
#endif
#ifndef REP_NSA
#define REP_NSA 1
#endif
#ifndef REP_GU
#define REP_GU 1
#endif
#ifndef REP_IN
#define REP_IN 1
#endif
template <class Epi, class Sched> __device__ __forceinline__ void run_gemm(LAS unsigned char* lds, const pg8::Gemm& g, const Sched& S, const Epi& E) {
    pg8::gemm_phase<Epi, Sched, !Epi::AFTER_DRAIN, true>(lds, g, S, E);
}
__global__ void __launch_bounds__(512, 2) mk_fwd(Params P) {
    extern __shared__ __attribute__((aligned(16))) unsigned char lds_raw[];
    LAS unsigned char* lds = (LAS unsigned char*)lds_raw;
    cg::grid_group grid = cg::this_grid();
    volatile LAS unsigned* bst = (volatile LAS unsigned*)(lds + LDS_BYTES - 64);
    if (threadIdx.x < 2) bst[threadIdx.x] = 0u;
    __syncthreads();
    XcdBarrier xbar = xcd_barrier_post((unsigned*)(P.ws + WS_BAR), bst);
    if (P.ph_hi - P.ph_lo > 1) grid.sync();
    unsigned char* ws = P.ws; const int G = gridDim.x, bx = blockIdx.x;
    const int vcu = (G % 8 == 0) ? (bx % 8) * (G / 8) + bx / 8 : bx;
    float* ssq = (float*)(ws + WS_SSQ);
    for (int ph = P.ph_lo; ph < P.ph_hi; ++ph) {
        if (ph >= 1 && ph < N_PHASES - 1 && (ph - 1) % 10 == 3) continue;
        if (ph > P.ph_lo) xcd_barrier(xbar);
        if (ph == 0) { for (int rep_ = 0; rep_ < REP_PREP; ++rep_) prep_phase(P, lds); continue; }
        if (ph == N_PHASES - 1) { final_phase(P); continue; }
        const int l = (ph - 1) / 10, k = (ph - 1) % 10;
        unsigned char* wl = ws + WS_W + (size_t)l * W_LAYER;
        const bf16_t* HB = (const bf16_t*)(ws + WS_HB);
        if (k == 0 || k == 8) {
            pg8::Gemm g{HB, (const bf16_t*)(wl + (k == 0 ? WO_GU1 : WO_GU2)), M, 2 * FF, D, D, D};
            pg8::StaticOrder S; S.init(M, 2 * FF, G, bx);
            fill_rs(lds, S, ssq);
            EpiGU E{(bf16_t*)(ws + WS_ACT), ssq, (const LAS float*)(lds + RS_OFF)};
            for (int rep_ = 1; rep_ < REP_GU; ++rep_) run_gemm(lds, g, S, E);
            run_gemm(lds, g, S, E);
        } else if (k == 1 || k == 7 || k == 9) {
            const bool isout = (k == 7);
            if (k == 1 && bx == G - 1) {
                const int t_ = opaque_tid(); const float* cbp = (const float*)(ws + WS_CBP) + ((size_t)(l * 2 + (t_ >> 8)) * 32) * 256 + (t_ & 255); float s_ = 0.f;
                for (int kc = 0; kc < 32; ++kc) s_ += cbp[kc * 256];
                ((float*)(ws + WS_CBIAS))[l * 512 + t_] = s_;
            }
            pg8::Gemm g{(const bf16_t*)(ws + (isout ? WS_Y : WS_ACT)), (const bf16_t*)(wl + (k == 1 ? WO_D1 : k == 7 ? WO_O : WO_D2)), M, D, isout ? D : FF, isout ? D : FF, isout ? D : FF};
            pg8::StaticOrder S; S.init(M, D, G, bx);
            EpiRes E{(const float*)nullptr, (bf16_t*)(ws + WS_HB), ssq, isout ? 1.f : 0.5f};
            run_gemm(lds, g, S, E);
        } else if (k == 2) {
            pg8::Gemm g{HB, (const bf16_t*)(wl + WO_IN), M, NIN, D, D, D};
            pg8::StaticOrder S; S.init(M, NIN, G, bx);
            fill_rs(lds, S, ssq);
            EpiIn E{ssq, (const float*)(ws + WS_ROPE), ws, (const LAS float*)(lds + RS_OFF)};
            for (int rep_ = 1; rep_ < REP_IN; ++rep_) run_gemm(lds, g, S, E);
            run_gemm(lds, g, S, E);
        } else if (k == 4) {
            const float* lp = P.in[I_LAM] + l * 256; const int lane = opaque_tid() & 63;
            const float s1 = wave_sum(lp[lane] * lp[64 + lane]), s2 = wave_sum(lp[128 + lane] * lp[192 + lane]);
            const float lam_init = 0.8f - 0.6f * expf(-0.3f * (float)l);
            const float lam = expf(s1) - expf(s2) + lam_init;
            for (int p = vcu; p < 256; p += G) {
                const int bh = p >> 3, i = p & 7;
                if (i == 0) {
                    pg8::Gemm g{(const bf16_t*)(ws + WS_KCR), (const bf16_t*)(wl + WO_C1), 8192, 512, 2048, 1024, 2048};
                    CmpOrder S{1 << 20, bh};
                    EpiCmp E{(const float*)(ws + WS_CBIAS) + l * 512, (const bf16_t*)(wl + WO_C2), (bf16_t*)(ws + WS_KC), (bf16_t*)(ws + WS_VCT)};
                    run_gemm(lds, g, S, E);
                }
                if ((opaque_tid() >> 6) < 4) __builtin_amdgcn_s_setprio(2);
                const int nu = (i == 0) ? 1 : (i == 7) ? 3 : 2;
#pragma unroll 1
                for (int uu = 0; uu < nu; ++uu) {
                    const int qb = (i == 0) ? 14 : (i == 7) ? (uu == 0 ? 8 : uu == 1 ? 7 : 0) : (uu == 0 ? (i == 1 ? 15 : 15 - i) : i);
                    att::diff_unit(lds, ws, P.out, bh >> 2, bh & 3, qb, lam, 1.f - lam_init);
                }
                __builtin_amdgcn_s_setprio(0);
            }
        } else if (k == 5) {
            if ((opaque_tid() >> 6) < 4) __builtin_amdgcn_s_setprio(2);
            for (int rep_ = 0; rep_ < REP_NSA; ++rep_)
            for (int p = vcu; p < 256; p += G) {
                const int bg = p >> 4, i = p & 15;
#pragma unroll 1
                for (int uu = 0; uu < 4; ++uu) { const int cur = (uu == 0) ? 63 - i : (uu == 1) ? 32 + i : (uu == 2) ? 31 - i : i; att::nsa_unit(lds, ws, P.out, bg >> 1, bg & 1, cur); }
            }
            __builtin_amdgcn_s_setprio(0);
        } else {
            BrOrder S; S.S0.init(M, D, G, bx);
            pg8::Gemm g{(const bf16_t*)oab_ptr(P.out), (const bf16_t*)(wl + WO_A), 2 * M, 2 * D, 512, 512, 512};
            EpiBr E{EpiBrA{(bf16_t*)(ws + WS_Y), (const bf16_t*)(ws + WS_GA)}, EpiBrB{(bf16_t*)(ws + WS_Y), (const bf16_t*)(ws + WS_GB)}};
            run_gemm(lds, g, S, E);
        }
    }
}

extern "C" void kernel_launch(void* const* d_in, const int* in_sizes, int n_in, void* d_out, int out_size, void* d_ws, size_t ws_size, hipStream_t stream) {
    static int grid = 0;
    if (grid == 0) {
        if (n_in != 18 || out_size != M * D || ws_size < WS_END) { fprintf(stderr, "kernel_launch: unexpected shapes (n_in %d out %d ws %zu)\n", n_in, out_size, ws_size); grid = -1; return; }
        int dev = 0, cus = 0, per_cu = 0;
        (void)hipGetDevice(&dev); (void)hipDeviceGetAttribute(&cus, hipDeviceAttributeMultiprocessorCount, dev);
        (void)hipFuncSetAttribute((const void*)mk_fwd, hipFuncAttributeMaxDynamicSharedMemorySize, LDS_BYTES);
        (void)hipOccupancyMaxActiveBlocksPerMultiprocessor(&per_cu, (const void*)mk_fwd, 512, LDS_BYTES);
        if (per_cu < 1) per_cu = 1;
        grid = cus * per_cu; if (grid > 256) grid = 256; if (grid < 32) grid = 32;
        (void)hipGetLastError();
    }
    if (grid < 0) return;
    (void)hipMemsetAsync((char*)d_ws + WS_BAR, 0, 16384, stream);
    Params p{};
    for (int i = 0; i < 18; ++i) p.in[i] = (const float*)d_in[i];
    p.out = (float*)d_out; p.ws = (unsigned char*)d_ws;
#if MK_MULTI
    for (int ph = 0; ph < N_PHASES; ++ph) { p.ph_lo = ph; p.ph_hi = ph + 1; hipLaunchKernelGGL(mk_fwd, dim3(grid), dim3(512), LDS_BYTES, stream, p); }
#else
    p.ph_lo = 0; p.ph_hi = N_PHASES;
    void* args[] = {&p};
    hipError_t e = hipLaunchCooperativeKernel((const void*)mk_fwd, dim3(grid), dim3(512), args, LDS_BYTES, stream);
    if (e != hipSuccess) fprintf(stderr, "cooperative launch failed: %s (grid %d)\n", hipGetErrorString(e), grid);
#endif
}
```

```cpp
#include <hip/hip_runtime.h>
#include <hip/hip_cooperative_groups.h>
#include <cstdio>
#include <cstdint>
#include <cmath>
namespace cg = cooperative_groups;
#ifndef MK_MULTI
#define MK_MULTI 0
#endif
__device__ __forceinline__ int opaque_tid() { int t = threadIdx.x; asm volatile("" : "+v"(t)); return t; }
__device__ __forceinline__ float my_shfl_xor(float v, int m) { const int l_ = opaque_tid() & 63; return __int_as_float(__builtin_amdgcn_ds_bpermute((l_ ^ m) << 2, __float_as_int(v))); }
namespace pg8 {
#define PG8_LAS __attribute__((address_space(3)))
typedef unsigned short bf16_t;
typedef short bf16x8 __attribute__((ext_vector_type(8)));
typedef float f32x4 __attribute__((ext_vector_type(4)));
typedef unsigned u32x4 __attribute__((ext_vector_type(4)));
constexpr int BM = 256, BK = 64, HALF = 128, HTB = HALF * BK * 2  , STAGE_BYTES = 8 * HTB, NXCD = 8, WGM = 8;

__host__ __device__ __forceinline__ int lds_byte(int r, int c) { const int st = (r >> 4) * 2 + (c >> 5), rr = r & 15, cc = c & 31, ob = rr * 64 + cc * 2; return st * 1024 + (ob ^ (((ob >> 9) & 1) << 5)); }
__host__ __device__ __forceinline__ void stage_rc(int b, int& R, int& C) { const int st = b / 1024, sb = b % 1024, swz = sb ^ (((sb >> 9) & 1) << 5); R = (st >> 1) * 16 + swz / 64; C = (st & 1) * 32 + (swz % 64) / 2; }
__host__ __device__ __forceinline__ int perm32(int rho) { const int n = rho >> 4, i = rho & 15; return 8 * (i >> 2) + 4 * n + (i & 3); }

struct Unit { int pm, pn, idx; };
struct Gemm { const bf16_t* A; const bf16_t* Bt; int M, N, K, lda, ldb; };

struct StaticOrder {
    int nM, nN, nwg, G, c;
    __host__ __device__ void init(int M, int N, int G_, int c_) { nM = M / BM; nN = N / BM; nwg = nM * nN; G = G_; c = c_; }
    __host__ __device__ bool next(int i, Unit& u) const {
        const long L = (long)i * G + c; if (L >= nwg) return false;
        int wgid = (int)L; { const int q = nwg / NXCD, r = nwg % NXCD, xcd = wgid % NXCD, off = wgid / NXCD; wgid = (xcd < r ? xcd * (q + 1) : r * (q + 1) + (xcd - r) * q) + off; }
        const int nig = WGM * nN, gid = wgid / nig, fm = gid * WGM, gsz = (nM - fm) < WGM ? (nM - fm) : WGM;
        u.pm = fm + ((wgid % nig) % gsz); u.pn = (wgid % nig) / gsz; u.idx = i; return true;
    }
    __device__ __forceinline__ void a_ready(const Unit&) const {}
    __device__ __forceinline__ void done(const Unit&) const {}
};

__device__ __forceinline__ unsigned cvt_pk_bf16(float lo, float hi) { unsigned r; asm volatile("v_cvt_pk_bf16_f32 %0, %1, %2" : "=v"(r) : "v"(lo), "v"(hi)); return r; }
typedef float f32x2 __attribute__((ext_vector_type(2)));
template <class Epi, class Sched, bool ALIGN_EPI = false, bool SP2 = false>
__device__ __forceinline__ void gemm_phase(PG8_LAS unsigned char* lds, const Gemm g, const Sched& S, const Epi& E) {
    const int tid = opaque_tid(), wid = __builtin_amdgcn_readfirstlane(tid >> 6), lane = tid & 63, wr = wid >> 2, wc = wid & 3, fr = lane & 15, fq = lane >> 4;
    const int K = g.K, nt = K / BK;
    unsigned voffA[2], voffB[2];
#pragma unroll
    for (int i = 0; i < 2; ++i) { int R, C; stage_rc(tid * 16 + i * 8192, R, C); const int Rb = Epi::PERM ? ((R & ~31) + perm32(R & 31)) : R;
        voffA[i] = (unsigned)(R * g.lda + C) * 2u; voffB[i] = (unsigned)(Rb * g.ldb + C) * 2u; }
    const size_t kstep = (size_t)(BK * 2);
    const size_t hstepA = (size_t)HALF * g.lda * 2, hstepB = (size_t)HALF * g.ldb * 2;
    const size_t tstepA = 2 * hstepA, tstepB = 2 * hstepB;
    const unsigned ldsw = (unsigned)wid * 1024u;
    const int aoff = lds_byte(wr * 64 + fr, fq * 8), boff = lds_byte(wc * 32 + fr, fq * 8);
#define PG8_SA(b, h) (((b) * 2 + (h)) * HTB)
#define PG8_SB(b, h) ((4 + (b) * 2 + (h)) * HTB)
#define PG8_STAGE(bufoff, gbase, voff) do { _Pragma("unroll") for (int _i = 0; _i < 2; ++_i) \
        __builtin_amdgcn_global_load_lds((const unsigned*)((const char*)(gbase) + (voff)[_i]), (PG8_LAS unsigned*)(lds + (bufoff) + ldsw + _i * 8192), 16, 0, 0); } while (0)
#define PG8_LDA(dst, b, h) do { _Pragma("unroll") for (int m = 0; m < 4; ++m) _Pragma("unroll") for (int k = 0; k < 2; ++k) dst[m][k] = *(const PG8_LAS bf16x8*)(lds + PG8_SA(b, h) + aoff + m * 2048 + k * 1024); } while (0)
#define PG8_LDB(dst, b, h) do { _Pragma("unroll") for (int n = 0; n < 2; ++n) _Pragma("unroll") for (int k = 0; k < 2; ++k) dst[n][k] = *(const PG8_LAS bf16x8*)(lds + PG8_SB(b, h) + boff + n * 2048 + k * 1024); } while (0)
#define PG8_MMA(ai, bj, At, Bt) do { __builtin_amdgcn_s_setprio(1); _Pragma("unroll") for (int m = 0; m < 4; ++m) _Pragma("unroll") for (int n = 0; n < 2; ++n) _Pragma("unroll") for (int k = 0; k < 2; ++k) \
        acc[ai][bj][m][n] = __builtin_amdgcn_mfma_f32_16x16x32_bf16(Bt[n][k], At[m][k], acc[ai][bj][m][n], 0, 0, 0); __builtin_amdgcn_s_setprio(0); } while (0)
#define PG8_WAIT_V(n) asm volatile("s_waitcnt vmcnt(" #n ")" ::: "memory")
#define PG8_WAIT_L(n) asm volatile("s_waitcnt lgkmcnt(" #n ")" ::: "memory")
#define PG8_BAR __builtin_amdgcn_s_barrier()
#define PG8_SCHED __builtin_amdgcn_sched_barrier(0)
    Unit cur, nxt; int ui = 0;
    if (!S.next(0, cur)) return;
    f32x4 acc[2][2][4][2];
#pragma unroll
    for (int a = 0; a < 2; ++a)
#pragma unroll
        for (int b = 0; b < 2; ++b)
#pragma unroll
            for (int m = 0; m < 4; ++m)
#pragma unroll
                for (int n = 0; n < 2; ++n) acc[a][b][m][n] = (f32x4){0.f, 0.f, 0.f, 0.f};
    bf16x8 At[4][2], B0[2][2], B1[2][2];
    const char* cA = (const char*)g.A + (size_t)cur.pm * tstepA; const char* cB = (const char*)g.Bt + (size_t)cur.pn * tstepB;
    S.a_ready(cur);
    if constexpr (SP2) {
        PG8_STAGE(PG8_SB(0, 0), cB, voffB); PG8_STAGE(PG8_SB(0, 1), cB + hstepB, voffB); PG8_STAGE(PG8_SA(0, 0), cA, voffA); PG8_STAGE(PG8_SA(0, 1), cA + hstepA, voffA);
        if (wr == 1) PG8_BAR;
        PG8_WAIT_V(2); PG8_BAR;
        PG8_STAGE(PG8_SB(1, 0), cB + kstep, voffB); PG8_STAGE(PG8_SA(1, 0), cA + kstep, voffA); PG8_STAGE(PG8_SB(1, 1), cB + hstepB + kstep, voffB);
        PG8_WAIT_V(6); PG8_BAR;
    } else {
        PG8_STAGE(PG8_SB(0, 0), cB, voffB); PG8_STAGE(PG8_SA(0, 0), cA, voffA); PG8_STAGE(PG8_SB(0, 1), cB + hstepB, voffB); PG8_STAGE(PG8_SA(0, 1), cA + hstepA, voffA);
        if (wr == 1) PG8_BAR;
        PG8_WAIT_V(4); PG8_BAR;
        PG8_STAGE(PG8_SB(1, 0), cB + kstep, voffB); PG8_STAGE(PG8_SA(1, 0), cA + kstep, voffA); PG8_STAGE(PG8_SB(1, 1), cB + hstepB + kstep, voffB);
        PG8_WAIT_V(6); PG8_BAR;
    }
    for (;;) {
        const bool has_next = S.next(ui + 1, nxt);
        const char* nA = has_next ? (const char*)g.A + (size_t)nxt.pm * tstepA : cA; const char* nB = has_next ? (const char*)g.Bt + (size_t)nxt.pn * tstepB : cB;
        for (int t = 0; t < nt; t += 2) {
            const bool last = (t == nt - 2);
            const char* a1 = cA + (size_t)(t + 1) * kstep;
            const char* a2 = last ? nA : cA + (size_t)(t + 2) * kstep; const char* b2 = last ? nB : cB + (size_t)(t + 2) * kstep;
            const char* a3 = a2 + kstep; const char* b3 = b2 + kstep;
            if (last && has_next) S.a_ready(nxt);
            if constexpr (SP2) {
            PG8_LDB(B0, 0, 0); PG8_LDB(B1, 0, 1); PG8_SCHED; PG8_LDA(At, 0, 0); PG8_STAGE(PG8_SA(1, 1), a1 + hstepA, voffA);
            PG8_WAIT_V(8); PG8_WAIT_L(0); PG8_BAR; PG8_MMA(0, 0, At, B0); PG8_MMA(0, 1, At, B1); PG8_BAR; PG8_SCHED;
            PG8_LDA(At, 0, 1); PG8_STAGE(PG8_SB(0, 0), b2, voffB); PG8_STAGE(PG8_SB(0, 1), b2 + hstepB, voffB); PG8_STAGE(PG8_SA(0, 0), a2, voffA);
            PG8_WAIT_V(8); PG8_WAIT_L(0); PG8_BAR; PG8_MMA(1, 0, At, B0); PG8_MMA(1, 1, At, B1); PG8_BAR; PG8_SCHED;
            PG8_LDB(B0, 1, 0); PG8_LDB(B1, 1, 1); PG8_SCHED; PG8_LDA(At, 1, 0); PG8_STAGE(PG8_SA(0, 1), a2 + hstepA, voffA);
            PG8_WAIT_V(8); PG8_WAIT_L(0); PG8_BAR; PG8_MMA(0, 0, At, B0); PG8_MMA(0, 1, At, B1); PG8_BAR; PG8_SCHED;
            PG8_LDA(At, 1, 1); PG8_STAGE(PG8_SB(1, 0), b3, voffB); PG8_STAGE(PG8_SB(1, 1), b3 + hstepB, voffB); PG8_STAGE(PG8_SA(1, 0), a3, voffA);
            PG8_WAIT_V(8); PG8_WAIT_L(0); PG8_BAR; PG8_MMA(1, 0, At, B0); PG8_MMA(1, 1, At, B1); PG8_BAR; PG8_SCHED;
            } else {
            PG8_LDB(B0, 0, 0); PG8_SCHED; PG8_LDA(At, 0, 0); PG8_STAGE(PG8_SA(1, 1), a1 + hstepA, voffA);
            PG8_WAIT_L(8); PG8_BAR; PG8_WAIT_L(0); PG8_MMA(0, 0, At, B0); PG8_BAR; PG8_SCHED;
            PG8_LDB(B1, 0, 1); PG8_STAGE(PG8_SB(0, 0), b2, voffB);
            PG8_BAR; PG8_WAIT_L(0); PG8_MMA(0, 1, At, B1); PG8_BAR;
            PG8_LDA(At, 0, 1); PG8_STAGE(PG8_SA(0, 0), a2, voffA);
            PG8_BAR; PG8_WAIT_L(0); PG8_MMA(1, 0, At, B0); PG8_BAR; PG8_SCHED;
            PG8_STAGE(PG8_SB(0, 1), b2 + hstepB, voffB);
            PG8_WAIT_V(6); PG8_BAR; PG8_MMA(1, 1, At, B1); PG8_BAR;
            PG8_LDB(B0, 1, 0); PG8_SCHED; PG8_LDA(At, 1, 0); PG8_STAGE(PG8_SA(0, 1), a2 + hstepA, voffA);
            PG8_WAIT_L(8); PG8_BAR; PG8_WAIT_L(0); PG8_MMA(0, 0, At, B0); PG8_BAR; PG8_SCHED;
            PG8_LDB(B1, 1, 1); PG8_STAGE(PG8_SB(1, 0), b3, voffB);
            PG8_BAR; PG8_WAIT_L(0); PG8_MMA(0, 1, At, B1); PG8_BAR;
            PG8_LDA(At, 1, 1); PG8_STAGE(PG8_SA(1, 0), a3, voffA);
            PG8_BAR; PG8_WAIT_L(0); PG8_MMA(1, 0, At, B0); PG8_BAR; PG8_SCHED;
            PG8_STAGE(PG8_SB(1, 1), b3 + hstepB, voffB);
            PG8_WAIT_V(6); PG8_BAR; PG8_MMA(1, 1, At, B1); PG8_BAR;
            }
        }
        if constexpr (ALIGN_EPI) { if (wr == 0) PG8_BAR; }
        if constexpr (!Epi::AFTER_DRAIN) { E(acc, cur, wr, wc, fr, fq); S.done(cur); }
        if (!has_next) break;
#pragma unroll
        for (int a = 0; a < 2; ++a)
#pragma unroll
            for (int b = 0; b < 2; ++b)
#pragma unroll
                for (int m = 0; m < 4; ++m)
#pragma unroll
                    for (int n = 0; n < 2; ++n) acc[a][b][m][n] = (f32x4){0.f, 0.f, 0.f, 0.f};
        cur = nxt; cA = nA; cB = nB; ++ui;
        if constexpr (ALIGN_EPI) { if (wr == 1) PG8_BAR; }
    }
    PG8_WAIT_V(0);
    if constexpr (!ALIGN_EPI) { if (wr == 0) PG8_BAR; }
    PG8_BAR;
    if constexpr (Epi::AFTER_DRAIN) { E.fused(acc, cur, wr, wc, fr, fq, lds, wid, lane); S.done(cur); }
#undef PG8_SA
#undef PG8_SB
#undef PG8_STAGE
#undef PG8_LDA
#undef PG8_LDB
#undef PG8_MMA
#undef PG8_WAIT_V
#undef PG8_WAIT_L
#undef PG8_BAR
#undef PG8_SCHED
}
}

using pg8::bf16_t; using pg8::bf16x8; using pg8::f32x4; using pg8::u32x4;
#define LAS __attribute__((address_space(3)))
typedef float f32x16 __attribute__((ext_vector_type(16)));
typedef float f32x2v __attribute__((ext_vector_type(2)));
typedef __bf16 bf16x2v __attribute__((ext_vector_type(2)));
constexpr int NB = 8, T = 4096, D = 1024, M = NB * T, FF = 2816, NL = 2, NIN = 5120;
constexpr float EPS = 1e-6f;
constexpr float C2 = 0.125f * 1.4426950408889634f;
constexpr size_t MiB = 1u << 20;
constexpr size_t WS_SSQ = 0;
constexpr size_t WS_CBP = 2 * MiB;
constexpr size_t WS_CBIAS = WS_CBP + 128 * 1024;
constexpr size_t WS_BAR = WS_CBP + 256 * 1024;
constexpr size_t WS_W = 3 * MiB, W_LAYER = 50 * MiB;
constexpr size_t WO_GU1 = 0, WO_D1 = WO_GU1 + 5632ull * 1024 * 2, WO_GU2 = WO_D1 + 1024ull * 2816 * 2, WO_D2 = WO_GU2 + 5632ull * 1024 * 2,
                 WO_IN = WO_D2 + 1024ull * 2816 * 2, WO_C1 = WO_IN + 5120ull * 1024 * 2, WO_C2 = WO_C1 + 2ull * 256 * 2048 * 2,
                 WO_A = WO_C2 + 2ull * 64 * 256 * 2, WO_B = WO_A + 1024ull * 512 * 2, WO_O = WO_B + 1024ull * 512 * 2, WO_END = WO_O + 1024ull * 1024 * 2;
static_assert(WO_END <= W_LAYER, "weights per layer");
constexpr size_t WS_ROPE = WS_W + NL * W_LAYER;
constexpr size_t WS_HB = WS_ROPE + 2 * MiB;
constexpr size_t WS_BIG = WS_HB + 64 * MiB;
constexpr size_t WS_ACT = WS_BIG;
constexpr size_t WS_QD = WS_BIG, WS_KD = WS_QD + 32 * MiB, WS_VDT = WS_KD + 32 * MiB, WS_QN = WS_VDT + 32 * MiB, WS_KCR = WS_QN + 32 * MiB,
                 WS_KS = WS_KCR + 17 * MiB, WS_KW = WS_KS + 8 * MiB, WS_VST = WS_KW + 8 * MiB, WS_VWT = WS_VST + 8 * MiB, WS_GA = WS_VWT + 8 * MiB,
                 WS_GB = WS_GA + 64 * MiB, WS_GN = WS_GB + 64 * MiB, WS_KC = WS_GN + 3 * MiB, WS_VCT = WS_KC + MiB / 2, WS_OA = WS_VCT + MiB,
                 WS_END = WS_OA + 32 * MiB;
__device__ __forceinline__ bf16_t* oab_ptr(float* out) { return (bf16_t*)((unsigned char*)out + 64 * MiB); }
constexpr size_t WS_Y = WS_KD;
static_assert(WS_END <= 512 * MiB, "workspace");
static_assert(WS_ACT + (size_t)M * FF * 2 <= WS_END, "ACT overlay");
constexpr int LDS_BYTES = 147456;

__device__ __forceinline__ unsigned cvtpk(float lo, float hi) { f32x2v v = {lo, hi}; bf16x2v b = __builtin_convertvector(v, bf16x2v); return __builtin_bit_cast(unsigned, b); }
__device__ __forceinline__ bf16_t f2bf(float x) { return (bf16_t)(cvtpk(x, 0.f) & 0xffffu); }
__device__ __forceinline__ float bflo(unsigned w) { return __uint_as_float(w << 16); }
__device__ __forceinline__ float bfhi(unsigned w) { return __uint_as_float(w & 0xffff0000u); }
__device__ __forceinline__ float sigm(float x) { return __builtin_amdgcn_rcpf(1.f + __expf(-x)); }
__device__ __forceinline__ float silu(float x) { return x * sigm(x); }
__device__ __forceinline__ float rowscale(const float* ssqp, int row) {
    const f32x4* p = (const f32x4*)(ssqp + (size_t)row * 16); const f32x4 a = p[0], b = p[1], c = p[2], d = p[3];
    const float s = (((a[0] + a[1]) + (a[2] + a[3])) + ((b[0] + b[1]) + (b[2] + b[3]))) + (((c[0] + c[1]) + (c[2] + c[3])) + ((d[0] + d[1]) + (d[2] + d[3])));
    return rsqrtf(s * (1.f / 1024.f) + EPS);
}
__device__ __forceinline__ int swap23(int t) { return (t & ~12) | ((t & 4) << 1) | ((t & 8) >> 1); }
__device__ __forceinline__ u32x4 pack8(const float (&v)[8]) { u32x4 w; w.x = cvtpk(v[0], v[1]); w.y = cvtpk(v[2], v[3]); w.z = cvtpk(v[4], v[5]); w.w = cvtpk(v[6], v[7]); return w; }

constexpr int RS_OFF = 131072, RS_MAXU = 15;
template <class Sched> __device__ __forceinline__ void fill_rs(LAS unsigned char* lds, const Sched& S, const float* ssq) {
    const int tid = opaque_tid(); LAS float* tab = (LAS float*)(lds + RS_OFF); pg8::Unit u;
    for (int i = 0; i < RS_MAXU && S.next(i, u); ++i) if (tid < 256) tab[i * 256 + tid] = rowscale(ssq, u.pm * 256 + tid);
    __syncthreads();
}
__device__ __forceinline__ float rs_get(const LAS float* tab, const float* ssq, const pg8::Unit& u, int row) { return u.idx < RS_MAXU ? tab[u.idx * 256 + (row & 255)] : rowscale(ssq, row); }
struct EpiGU {
    static constexpr bool PERM = true, AFTER_DRAIN = false;
    bf16_t* ACT; const float* ssq; const LAS float* rst;
    __device__ __forceinline__ void operator()(const f32x4 (&acc)[2][2][4][2], const pg8::Unit& u, int wr, int wc, int fr, int fq) const {
        const int row0 = u.pm * 256 + wr * 64 + fr, col0 = u.pn * 128 + wc * 32 + fq * 8;
#pragma unroll
        for (int ai = 0; ai < 2; ++ai)
#pragma unroll
            for (int m = 0; m < 4; ++m) {
                const int row = row0 + ai * 128 + m * 16; const float rs = rs_get(rst, ssq, u, row);
                float v[8];
#pragma unroll
                for (int n = 0; n < 2; ++n)
#pragma unroll
                    for (int e = 0; e < 4; ++e) { const float g = acc[ai][0][m][n][e] * rs, uu = acc[ai][1][m][n][e] * rs; v[n * 4 + e] = silu(g) * uu; }
                *(u32x4*)(ACT + (size_t)row * FF + col0) = pack8(v);
            }
    }
};
struct EpiRes {
    static constexpr bool PERM = true, AFTER_DRAIN = false;
    const float* Xin; bf16_t* HB; float* ssq_out; float f;
    __device__ __forceinline__ void operator()(const f32x4 (&acc)[2][2][4][2], const pg8::Unit& u, int wr, int wc, int fr, int fq) const {
        const int row0 = u.pm * 256 + wr * 64 + fr, col0 = u.pn * 256 + wc * 32 + fq * 8;
        u32x4 raw[2][4][2];
#pragma unroll
        for (int ai = 0; ai < 2; ++ai)
#pragma unroll
            for (int m = 0; m < 4; ++m)
#pragma unroll
                for (int bj = 0; bj < 2; ++bj) raw[ai][m][bj] = *(const u32x4*)((const char*)HB + (unsigned)(((row0 + ai * 128 + m * 16) * D + col0 + bj * 128) * 2));
        asm volatile("" ::: "memory");
#pragma unroll
        for (int ai = 0; ai < 2; ++ai)
#pragma unroll
            for (int m = 0; m < 4; ++m) {
                const int row = row0 + ai * 128 + m * 16; float ss = 0.f;
#pragma unroll
                for (int bj = 0; bj < 2; ++bj) {
                    const u32x4 q = raw[ai][m][bj];
                    const f32x4 h0 = (f32x4){bflo(q.x), bfhi(q.x), bflo(q.y), bfhi(q.y)} + acc[ai][bj][m][0] * f, h1 = (f32x4){bflo(q.z), bfhi(q.z), bflo(q.w), bfhi(q.w)} + acc[ai][bj][m][1] * f;
                    u32x4 w; w.x = cvtpk(h0[0], h0[1]); w.y = cvtpk(h0[2], h0[3]); w.z = cvtpk(h1[0], h1[1]); w.w = cvtpk(h1[2], h1[3]);
                    *(u32x4*)((char*)HB + (unsigned)((row * D + col0 + bj * 128) * 2)) = w;
                    const float r0 = bflo(w.x), r1 = bfhi(w.x), r2 = bflo(w.y), r3 = bfhi(w.y), r4 = bflo(w.z), r5 = bfhi(w.z), r6 = bflo(w.w), r7 = bfhi(w.w);
                    ss += (r0 * r0 + r1 * r1) + (r2 * r2 + r3 * r3) + (r4 * r4 + r5 * r5) + (r6 * r6 + r7 * r7);
                }
                ss += my_shfl_xor(ss, 16); ss += my_shfl_xor(ss, 32);
                if (fq == 0) ssq_out[(unsigned)(row * 16 + u.pn * 4 + wc)] = ss;
            }
    }
};
struct EpiBrA {
    static constexpr bool PERM = true, AFTER_DRAIN = false;
    bf16_t* Y; const bf16_t* G;
    __device__ __forceinline__ void operator()(const f32x4 (&acc)[2][2][4][2], const pg8::Unit& u, int wr, int wc, int fr, int fq) const {
        const int row0 = u.pm * 256 + wr * 64 + fr, col0 = u.pn * 256 + wc * 32 + fq * 8;
        u32x4 g[2][4][2];
#pragma unroll
        for (int ai = 0; ai < 2; ++ai)
#pragma unroll
            for (int m = 0; m < 4; ++m)
#pragma unroll
                for (int bj = 0; bj < 2; ++bj) g[ai][m][bj] = *(const u32x4*)(G + (size_t)(row0 + ai * 128 + m * 16) * D + col0 + bj * 128);
        asm volatile("" ::: "memory");
#pragma unroll
        for (int ai = 0; ai < 2; ++ai)
#pragma unroll
            for (int m = 0; m < 4; ++m)
#pragma unroll
                for (int bj = 0; bj < 2; ++bj) {
                    const size_t off = (size_t)(row0 + ai * 128 + m * 16) * D + col0 + bj * 128; float v[8];
#pragma unroll
                    for (int k = 0; k < 4; ++k) { v[2 * k] = bflo(g[ai][m][bj][k]) * acc[ai][bj][m][k >> 1][(2 * k) & 3]; v[2 * k + 1] = bfhi(g[ai][m][bj][k]) * acc[ai][bj][m][k >> 1][(2 * k + 1) & 3]; }
                    *(u32x4*)(Y + off) = pack8(v);
                }
    }
};
struct EpiBrB {
    static constexpr bool PERM = true, AFTER_DRAIN = false;
    bf16_t* Y; const bf16_t* G;
    __device__ __forceinline__ void operator()(const f32x4 (&acc)[2][2][4][2], const pg8::Unit& u, int wr, int wc, int fr, int fq) const {
        const int row0 = u.pm * 256 + wr * 64 + fr, col0 = u.pn * 256 + wc * 32 + fq * 8;
#pragma unroll
        for (int ai = 0; ai < 2; ++ai) {
            u32x4 g[4][2], y[4][2];
#pragma unroll
            for (int m = 0; m < 4; ++m)
#pragma unroll
                for (int bj = 0; bj < 2; ++bj) { const size_t off = (size_t)(row0 + ai * 128 + m * 16) * D + col0 + bj * 128; g[m][bj] = *(const u32x4*)(G + off); y[m][bj] = *(const u32x4*)(Y + off); }
            asm volatile("" ::: "memory");
#pragma unroll
            for (int m = 0; m < 4; ++m)
#pragma unroll
                for (int bj = 0; bj < 2; ++bj) {
                    const size_t off = (size_t)(row0 + ai * 128 + m * 16) * D + col0 + bj * 128; float v[8];
#pragma unroll
                    for (int k = 0; k < 4; ++k) { v[2 * k] = bflo(y[m][bj][k]) + bflo(g[m][bj][k]) * acc[ai][bj][m][k >> 1][(2 * k) & 3]; v[2 * k + 1] = bfhi(y[m][bj][k]) + bfhi(g[m][bj][k]) * acc[ai][bj][m][k >> 1][(2 * k + 1) & 3]; }
                    *(u32x4*)(Y + off) = pack8(v);
                }
            asm volatile("" ::: "memory");
        }
    }
};
struct BrOrder {
    pg8::StaticOrder S0;
    __device__ __forceinline__ bool next(int i, pg8::Unit& u) const { pg8::Unit v; if (!S0.next(i >> 1, v)) return false; u.pm = v.pm + (i & 1) * (M / 256); u.pn = v.pn + (i & 1) * (D / 256); u.idx = i; return true; }
    __device__ __forceinline__ void a_ready(const pg8::Unit&) const {}
    __device__ __forceinline__ void done(const pg8::Unit&) const {}
};
struct EpiBr {
    static constexpr bool PERM = true, AFTER_DRAIN = false;
    EpiBrA ea; EpiBrB eb;
    __device__ __forceinline__ void operator()(const f32x4 (&acc)[2][2][4][2], const pg8::Unit& u, int wr, int wc, int fr, int fq) const {
        if (u.pm < M / 256) ea(acc, u, wr, wc, fr, fq);
        else { pg8::Unit v; v.pm = u.pm - M / 256; v.pn = u.pn - D / 256; v.idx = u.idx; eb(acc, v, wr, wc, fr, fq); }
    }
};
__device__ __forceinline__ unsigned quad_x(unsigned v, int ctrl_b1) { return ctrl_b1 ? (unsigned)__builtin_amdgcn_update_dpp(0, (int)v, 0x4E, 0xF, 0xF, false) : (unsigned)__builtin_amdgcn_update_dpp(0, (int)v, 0xB1, 0xF, 0xF, false); }
__device__ __forceinline__ void store_vt_quad(bf16_t* rowbase  , int t, const float (&v)[8]) {
    const int j = opaque_tid() & 3; const bool odd = (j & 1) != 0, up = (j & 2) != 0;
    const unsigned w0 = cvtpk(v[0], v[1]), w1 = cvtpk(v[2], v[3]), w2 = cvtpk(v[4], v[5]), w3 = cvtpk(v[6], v[7]);
    const unsigned r01 = quad_x(odd ? w0 : w1, 0), r23 = quad_x(odd ? w2 : w3, 0);
    const unsigned n0 = odd ? r01 : w0, n1 = odd ? w1 : r01, n2 = odd ? r23 : w2, n3 = odd ? w3 : r23;
    const unsigned rA = quad_x(up ? n0 : n2, 1), rB = quad_x(up ? n1 : n3, 1);
    const unsigned T0 = up ? rA : n0, T1 = up ? rB : n1, T2 = up ? n2 : rA, T3 = up ? n3 : rB;
    const unsigned a0 = __builtin_amdgcn_perm(T1, T0, 0x05040100u), a1 = __builtin_amdgcn_perm(T3, T2, 0x05040100u);
    const unsigned b0 = __builtin_amdgcn_perm(T1, T0, 0x07060302u), b1 = __builtin_amdgcn_perm(T3, T2, 0x07060302u);
    bf16_t* p = rowbase + (size_t)(2 * j) * T + swap23(t & ~3);
    *(unsigned long long*)p = (unsigned long long)a0 | ((unsigned long long)a1 << 32);
    *(unsigned long long*)(p + T) = (unsigned long long)b0 | ((unsigned long long)b1 << 32);
}
struct EpiIn {
    static constexpr bool PERM = true, AFTER_DRAIN = false;
    const float* ssq; const float* rope; unsigned char* ws; const LAS float* rst;
    __device__ __forceinline__ void chunk(int pn, int colt, int row, float (&v)[8], int fq, const f32x4& c, const f32x4& s) const {
        const int b = row >> 12, t = row & (T - 1);
        if (pn < 8) {
            const int buf = pn >> 1, col = (pn & 1) * 256 + colt;
            if (buf == 2) {
                store_vt_quad((bf16_t*)(ws + WS_VDT) + ((size_t)(b * 4 + (col >> 7)) * 128 + (col & 127)) * T, t, v);
            } else {
                if ((colt & 63) < 16) {
#pragma unroll
                    for (int k = 0; k < 4; ++k) { const float x1 = v[2 * k], x2 = v[2 * k + 1]; v[2 * k] = x1 * c[k] - x2 * s[k]; v[2 * k + 1] = x2 * c[k] + x1 * s[k]; } }
                if (buf != 1) {
#pragma unroll
                    for (int i = 0; i < 8; ++i) v[i] *= C2; }
                bf16_t* base = (bf16_t*)(ws + (buf == 0 ? WS_QD : buf == 1 ? WS_KD : WS_QN));
                *(u32x4*)(base + (size_t)row * 512 + col) = pack8(v);
            }
        } else if (pn == 8) {
            const int kv = colt >> 7, g = (colt >> 6) & 1, d = colt & 63;
            *(u32x4*)((bf16_t*)(ws + WS_KCR) + ((size_t)((kv * NB + b) * 2 + g) * T + t) * 64 + d) = pack8(v);
        } else if (pn < 11) {
            if (colt < 128) {
                if ((colt & 63) < 16) {
#pragma unroll
                    for (int k = 0; k < 4; ++k) { const float x1 = v[2 * k], x2 = v[2 * k + 1]; v[2 * k] = x1 * c[k] - x2 * s[k]; v[2 * k + 1] = x2 * c[k] + x1 * s[k]; } }
                *(u32x4*)((bf16_t*)(ws + (pn == 9 ? WS_KS : WS_KW)) + (size_t)row * 128 + colt) = pack8(v);
            } else {
                const int g = (colt - 128) >> 6, d = colt & 63;
                store_vt_quad((bf16_t*)(ws + (pn == 9 ? WS_VST : WS_VWT)) + ((size_t)(b * 2 + g) * 64 + d) * T, t, v);
            }
        } else if (pn < 19) {
#pragma unroll
            for (int i = 0; i < 8; ++i) v[i] = sigm(v[i]);
            bf16_t* base = (bf16_t*)(ws + (pn < 15 ? WS_GA : WS_GB));
            *(u32x4*)(base + (size_t)row * D + ((pn - 11) & 3) * 256 + colt) = pack8(v);
        } else {
            if (colt < 24) { float* p = (float*)(ws + WS_GN) + (size_t)row * 24 + colt;
#pragma unroll
                for (int i = 0; i < 8; ++i) p[i] = sigm(v[i]); }
        }
    }
    __device__ __forceinline__ void operator()(const f32x4 (&acc)[2][2][4][2], const pg8::Unit& u, int wr, int wc, int fr, int fq) const {
        const int row0 = u.pm * 256 + wr * 64 + fr; const int pn = u.pn;
        const bool ropetile = (pn < 4) || pn == 6 || pn == 7 || pn == 9 || pn == 10;
#pragma unroll
        for (int ai = 0; ai < 2; ++ai) {
            f32x4 rc[4], rsn[4];
#pragma unroll
            for (int m = 0; m < 4; ++m) {
                if (ropetile) { const float* rp = rope + (size_t)(row0 + ai * 128 + m * 16) * 16 + 4 * (fq & 1); rc[m] = *(const f32x4*)rp; rsn[m] = *(const f32x4*)(rp + 8); }
                else { rc[m] = (f32x4){1.f, 1.f, 1.f, 1.f}; rsn[m] = (f32x4){0.f, 0.f, 0.f, 0.f}; }
            }
#pragma unroll
            for (int m = 0; m < 4; ++m) {
                const int row = row0 + ai * 128 + m * 16; const float rs = rs_get(rst, ssq, u, row);
#pragma unroll
                for (int bj = 0; bj < 2; ++bj) {
                    float v[8];
#pragma unroll
                    for (int n = 0; n < 2; ++n)
#pragma unroll
                        for (int e = 0; e < 4; ++e) v[n * 4 + e] = acc[ai][bj][m][n][e] * rs;
                    chunk(pn, bj * 128 + wc * 32 + fq * 8, row, v, fq, rc[m], rsn[m]);
                }
            }
            asm volatile("" ::: "memory");
        }
    }
};
struct CmpOrder {
    int G, c;
    __device__ __forceinline__ bool next(int i, pg8::Unit& u) const { const int L = i * G + c; if (L >= 32) return false; u.pm = L; u.pn = L >> 4; u.idx = i; return true; }
    __device__ __forceinline__ void a_ready(const pg8::Unit&) const {}
    __device__ __forceinline__ void done(const pg8::Unit&) const {}
};
struct EpiCmp {
    static constexpr bool PERM = false, AFTER_DRAIN = true;
    const float* cbias;
    const bf16_t* W2t;
    bf16_t* KC; bf16_t* VCT;
    __device__ __forceinline__ void fused(f32x4 (&acc)[2][2][4][2], const pg8::Unit& u, int wr, int wc, int fr, int fq, LAS unsigned char* lds, int wid, int lane) const {
        const int kv = u.pn, bg = u.pm & 15;
        const float* bias = cbias + kv * 256;
#pragma unroll
        for (int bj = 0; bj < 2; ++bj)
#pragma unroll
            for (int n = 0; n < 2; ++n) {
                const int c0 = bj * 128 + wc * 32 + n * 16 + fq * 4; const f32x4 bv = *(const f32x4*)(bias + c0);
#pragma unroll
                for (int ai = 0; ai < 2; ++ai)
#pragma unroll
                    for (int m = 0; m < 4; ++m) {
                        const int r = ai * 128 + wr * 64 + m * 16 + fr; const f32x4 x = acc[ai][bj][m][n] + bv;
                        unsigned w0 = cvtpk(silu(x[0]), silu(x[1])), w1 = cvtpk(silu(x[2]), silu(x[3]));
                        LAS unsigned* p = (LAS unsigned*)(lds + r * 528 + c0 * 2); p[0] = w0; p[1] = w1;
                    }
            }
        __syncthreads();
        const int r32 = lane & 31, hi = lane >> 5;
        f32x16 o0 = {}, o1 = {};
        const bf16_t* wp = W2t + (size_t)kv * 64 * 256;
#pragma unroll 4
        for (int ks = 0; ks < 16; ++ks) {
            const bf16x8 a = *(const LAS bf16x8*)(lds + (wid * 32 + r32) * 528 + (ks * 16 + hi * 8) * 2);
            const bf16x8 b0 = *(const bf16x8*)(wp + (size_t)r32 * 256 + ks * 16 + hi * 8), b1 = *(const bf16x8*)(wp + (size_t)(32 + r32) * 256 + ks * 16 + hi * 8);
            o0 = __builtin_amdgcn_mfma_f32_32x32x16_bf16(a, b0, o0, 0, 0, 0); o1 = __builtin_amdgcn_mfma_f32_32x32x16_bf16(a, b1, o1, 0, 0, 0);
        }
#pragma unroll
        for (int r = 0; r < 16; ++r) {
            const int c = wid * 32 + (r & 3) + 8 * (r >> 2) + 4 * hi; const bool pad = (c == 255);
            const float v0 = pad ? 0.f : o0[r], v1 = pad ? 0.f : o1[r];
            if (kv == 0) { bf16_t* p = KC + ((size_t)bg * 256 + c) * 64; p[r32] = f2bf(v0); p[32 + r32] = f2bf(v1); }
            else { bf16_t* p = VCT + (size_t)bg * 128 * 256 + swap23(c); p[(size_t)r32 * 256] = f2bf(v0); p[(size_t)(32 + r32) * 256] = f2bf(v1); }
        }
        __syncthreads();
    }
};

namespace att {
constexpr int KSTRB = 144;
constexpr int KT_BYTES = 64 * KSTRB, VT_BYTES = 128 * KSTRB, BUF_BYTES = KT_BYTES + VT_BYTES;
constexpr int OFF_WSF = 2 * BUF_BYTES;
constexpr int OFF_IMP = OFF_WSF + 8 * 256;
constexpr int IMP_H = 64 * 65;
constexpr int OFF_SEL = OFF_IMP + 4 * IMP_H * 4;
constexpr int LDS_END = OFF_SEL + 64 * 8;
static_assert(LDS_END <= LDS_BYTES - 64 && OFF_IMP + 8 * 32 * 272 <= LDS_BYTES - 64, "attention LDS");
__device__ __forceinline__ int crow(int r, int hi) { return (r & 3) + 8 * (r >> 2) + 4 * hi; }
#define AT_NEG (-INFINITY)
#define AT_SB() __builtin_amdgcn_sched_barrier(0)
__device__ __forceinline__ float max3f(float a, float b, float c) { float r; asm("v_max3_f32 %0, %1, %2, %3" : "=v"(r) : "v"(a), "v"(b), "v"(c)); return r; }
__device__ __forceinline__ float lane32_max(float m) { auto rr = __builtin_amdgcn_permlane32_swap(__float_as_uint(m), __float_as_uint(m), false, false); return fmaxf(__uint_as_float(rr[0]), __uint_as_float(rr[1])); }
__device__ __forceinline__ float lane32_sum(float m) { auto rr = __builtin_amdgcn_permlane32_swap(__float_as_uint(m), __float_as_uint(m), false, false); return __uint_as_float(rr[0]) + __uint_as_float(rr[1]); }

__device__ __forceinline__ void qk_tile(f32x16& s0, f32x16& s1, const LAS unsigned char* Ks, const bf16x8 (&qf)[4], int r32, int hi) {
    const LAS unsigned char* kb = Ks + r32 * KSTRB + hi * 16;
    s0 = (f32x16){}; s1 = (f32x16){};
#pragma unroll
    for (int d0 = 0; d0 < 4; ++d0) {
        const bf16x8 a0 = *(const LAS bf16x8*)(kb + d0 * 32), a1 = *(const LAS bf16x8*)(kb + 32 * KSTRB + d0 * 32);
        s0 = __builtin_amdgcn_mfma_f32_32x32x16_bf16(a0, qf[d0], s0, 0, 0, 0);
        s1 = __builtin_amdgcn_mfma_f32_32x32x16_bf16(a1, qf[d0], s1, 0, 0, 0);
    }
}

template <int NDB, bool SEL>
__device__ __forceinline__ void tile_step(f32x16 (&o)[NDB], float& m_run, float& l_run, const LAS unsigned char* Ks, LAS float* wsf, const bf16x8 (&qf)[4],
    int t, int kv_lo, int kv_hi, int w_lo_min, int w_lo_max, int w_hi_min, int w_hi_max, unsigned long long selbits, int lane, int r32, int hi)
{
        const int kv0 = t * 64;
        bool skip = (kv0 > w_hi_max) || (kv0 + 63 < w_lo_min);
        bool bit = true;
        if (SEL) { bit = ((selbits >> t) & 1ull) != 0ull; if (!__any(bit)) skip = true; }
        if (!skip) {
            const LAS unsigned char* Vs = Ks + KT_BYTES;
            f32x16 s0, s1;
            { const LAS unsigned char* kb = Ks + r32 * KSTRB + hi * 16; bf16x8 kf[8];
#pragma unroll
              for (int d0 = 0; d0 < 4; ++d0) { kf[2 * d0] = *(const LAS bf16x8*)(kb + d0 * 32); kf[2 * d0 + 1] = *(const LAS bf16x8*)(kb + 32 * KSTRB + d0 * 32); }
              AT_SB();
              s0 = __builtin_amdgcn_mfma_f32_32x32x16_bf16(kf[0], qf[0], (f32x16){}, 0, 0, 0); s1 = __builtin_amdgcn_mfma_f32_32x32x16_bf16(kf[1], qf[0], (f32x16){}, 0, 0, 0);
#pragma unroll
              for (int d0 = 1; d0 < 4; ++d0) { s0 = __builtin_amdgcn_mfma_f32_32x32x16_bf16(kf[2 * d0], qf[d0], s0, 0, 0, 0); s1 = __builtin_amdgcn_mfma_f32_32x32x16_bf16(kf[2 * d0 + 1], qf[d0], s1, 0, 0, 0); }
              AT_SB(); }
            const LAS unsigned char* vb0 = Vs + r32 * KSTRB + hi * 16;
            bf16x8 vf[8];
#pragma unroll
            for (int i = 0; i < 8; ++i) vf[i] = *(const LAS bf16x8*)(vb0 + (i >> 2) * 32 * KSTRB + (i & 3) * 32);
            AT_SB();
            const bool full = (kv0 + 63 <= w_hi_min) && (kv0 >= w_lo_max);
            if (!full) {
#pragma unroll
                for (int r = 0; r < 16; ++r) { const int kv = kv0 + crow(r, hi); if (kv < kv_lo || kv > kv_hi) s0[r] = AT_NEG; if (kv + 32 < kv_lo || kv + 32 > kv_hi) s1[r] = AT_NEG; }
            }
            float mt = fmaxf(s0[0], s1[0]);
#pragma unroll
            for (int r = 1; r < 16; ++r) mt = fmaxf(mt, fmaxf(s0[r], s1[r]));
            if (SEL) mt = bit ? mt : AT_NEG;
            mt = lane32_max(mt);
            if (__any(mt > m_run + 8.f)) {
                const float m_new = fmaxf(m_run, mt);
                const float alpha = (m_new == AT_NEG) ? 1.f : __builtin_amdgcn_exp2f(m_run - m_new);
                l_run *= alpha; m_run = m_new;
                if (hi == 0) wsf[r32] = alpha;
#pragma unroll
                for (int r = 0; r < 16; ++r) { const float a = wsf[crow(r, hi)];
#pragma unroll
                    for (int db = 0; db < NDB; ++db) o[db][r] *= a; }
            }
            float mu = (m_run == AT_NEG) ? 0.f : m_run;
            if (SEL) mu = bit ? mu : INFINITY;
            float ps = 0.f;
#pragma unroll
            for (int r = 0; r < 16; ++r) { s0[r] = __builtin_amdgcn_exp2f(s0[r] - mu); s1[r] = __builtin_amdgcn_exp2f(s1[r] - mu); ps += s0[r] + s1[r]; }
            l_run += ps;
            u32x4 pa[4];
#pragma unroll
            for (int hf = 0; hf < 2; ++hf)
#pragma unroll
                for (int k = 0; k < 4; ++k) { pa[hf][k] = cvtpk(s0[8 * hf + 2 * k], s0[8 * hf + 2 * k + 1]); pa[2 + hf][k] = cvtpk(s1[8 * hf + 2 * k], s1[8 * hf + 2 * k + 1]); }
            AT_SB();
            if (NDB == 2) {
#pragma unroll
                for (int i = 0; i < 8; ++i) o[i >> 2] = __builtin_amdgcn_mfma_f32_32x32x16_bf16(__builtin_bit_cast(bf16x8, pa[i & 3]), vf[i], o[i >> 2], 0, 0, 0);
            } else {
                bf16x8 vg[8];
#pragma unroll
                for (int i = 0; i < 8; ++i) {
                    o[i >> 2] = __builtin_amdgcn_mfma_f32_32x32x16_bf16(__builtin_bit_cast(bf16x8, pa[i & 3]), vf[i], o[i >> 2], 0, 0, 0);
                    vg[i] = *(const LAS bf16x8*)(vb0 + (2 + (i >> 2)) * 32 * KSTRB + (i & 3) * 32);
                }
                AT_SB();
#pragma unroll
                for (int i = 0; i < 8; ++i) o[(NDB == 4 ? 2 : 0) + (i >> 2)] = __builtin_amdgcn_mfma_f32_32x32x16_bf16(__builtin_bit_cast(bf16x8, pa[i & 3]), vg[i], o[(NDB == 4 ? 2 : 0) + (i >> 2)], 0, 0, 0);
            }
            AT_SB();
        }
}

template <int NDB, bool SEL, bool ACC, bool IMP = false>
__device__ __forceinline__ void attn_pass(f32x16 (&oacc)[NDB], LAS unsigned char* shm, const bf16x8 (&qf)[4],
    const bf16_t* __restrict__ Kg, int kpitch, const bf16_t* __restrict__ VTg, int vpitch, int t0, int t1,
    int kv_lo, int kv_hi, int w_lo_min, int w_lo_max, int w_hi_min, int w_hi_max, unsigned long long selbits, float post, float& m_fin, float& il_fin)
{
    const int tid = opaque_tid(), lane = tid & 63, wid = tid >> 6, r32 = lane & 31, hi = lane >> 5;
    const int srow = tid >> 3, sch = tid & 7;
    LAS float* wsf = (LAS float*)(shm + OFF_WSF + wid * 256);
    f32x16 o[NDB];
#pragma unroll
    for (int db = 0; db < NDB; ++db) o[db] = (f32x16){};
    float m_run = AT_NEG, l_run = 0.f;
    u32x4 kA, vA[NDB / 2], kB, vB[NDB / 2];
    const bf16_t* kgp = Kg + (size_t)srow * kpitch + sch * 8; const bf16_t* vgp = VTg + (size_t)srow * vpitch + sch * 8;
#define AT_GLOAD(t, KR, VR) do { const int kv0_ = (t) * 64; KR = *(const u32x4*)(kgp + (size_t)kv0_ * kpitch); \
        _Pragma("unroll") for (int i_ = 0; i_ < NDB / 2; ++i_) VR[i_] = *(const u32x4*)(vgp + (size_t)(64 * i_) * vpitch + kv0_); } while (0)
#define AT_SSTORE(buf, KR, VR) do { LAS unsigned char* b_ = shm + (buf) * BUF_BYTES; *(LAS u32x4*)(b_ + srow * KSTRB + sch * 16) = KR; \
        _Pragma("unroll") for (int i_ = 0; i_ < NDB / 2; ++i_) *(LAS u32x4*)(b_ + KT_BYTES + (srow + 64 * i_) * KSTRB + sch * 16) = VR[i_]; } while (0)
    const int n = t1 - t0;
    if (n > 0) {
    AT_GLOAD(t0, kA, vA); AT_GLOAD(t0 + min(1, n - 1), kB, vB); AT_SSTORE(0, kA, vA);
    __syncthreads();
    for (int i = 0; i < n; i += 2) {
        AT_GLOAD(t0 + min(i + 2, n - 1), kA, vA);
        tile_step<NDB, SEL>(o, m_run, l_run, shm, wsf, qf, t0 + i, kv_lo, kv_hi, w_lo_min, w_lo_max, w_hi_min, w_hi_max, selbits, lane, r32, hi);
        AT_SSTORE(1, kB, vB);
        __syncthreads();
        if (i + 1 >= n) break;
        AT_GLOAD(t0 + min(i + 3, n - 1), kB, vB);
        tile_step<NDB, SEL>(o, m_run, l_run, shm + BUF_BYTES, wsf, qf, t0 + i + 1, kv_lo, kv_hi, w_lo_min, w_lo_max, w_hi_min, w_hi_max, selbits, lane, r32, hi);
        AT_SSTORE(0, kA, vA);
        __syncthreads();
    }
    }
#undef AT_GLOAD
#undef AT_SSTORE
    const float l_tot = lane32_sum(l_run);
    const float inv = l_tot > 0.f ? 1.f / l_tot : 0.f;
    m_fin = m_run; il_fin = inv;
    if (hi == 0) { wsf[r32] = inv * post; if (IMP) wsf[32 + r32] = inv; }
#pragma unroll
    for (int r = 0; r < 16; ++r) { const float a = wsf[crow(r, hi)]; const float a2 = IMP ? wsf[32 + crow(r, hi)] : a;
#pragma unroll
        for (int db = 0; db < NDB; ++db) { const float aa = (IMP && db >= 2) ? a2 : a; if (ACC) oacc[db][r] += o[db][r] * aa; else oacc[db][r] = o[db][r] * aa; } }
#pragma unroll
    for (int db = 0; db < NDB; ++db) asm volatile("" : "+v"(oacc[db]));
}

__device__ __forceinline__ void diff_unit(LAS unsigned char* shm, unsigned char* ws, float* scratch, int b, int h, int qb, float lam, float outscale) {
    const int tid = opaque_tid(), lane = tid & 63, wid = tid >> 6, r32 = lane & 31, hi = lane >> 5;
    const int q0 = qb * 256, qw0 = q0 + 32 * wid, qpos = qw0 + r32; const size_t row = (size_t)b * T + qpos;
    const bf16_t* QD = (const bf16_t*)(ws + WS_QD); const bf16_t* KD = (const bf16_t*)(ws + WS_KD); const bf16_t* VDT = (const bf16_t*)(ws + WS_VDT);
    f32x16 oacc[4];
    float mf, ilf;
    f32x4* o0s = (f32x4*)scratch + ((((size_t)b * T + qw0) >> 5) * 4 + h) * 1024 + lane;
    {
        bf16x8 qf[4];
#pragma unroll
        for (int d0 = 0; d0 < 4; ++d0) qf[d0] = *(const bf16x8*)(QD + row * 512 + h * 128 + d0 * 16 + hi * 8);
        attn_pass<4, false, false>(oacc, shm, qf, KD + (size_t)b * T * 512 + h * 128, 512, VDT + (size_t)(b * 4 + h) * 128 * T, T, 0, (q0 + 256) / 64,
                            0, qpos, 0, 0, qw0, qw0 + 31, 0ull, 1.f, mf, ilf);
#pragma unroll
        for (int db = 0; db < 4; ++db)
#pragma unroll
            for (int r4 = 0; r4 < 4; ++r4) o0s[(db * 4 + r4) * 64] = (f32x4){oacc[db][4 * r4], oacc[db][4 * r4 + 1], oacc[db][4 * r4 + 2], oacc[db][4 * r4 + 3]};
    }
    {
        bf16x8 qf[4];
#pragma unroll
        for (int d0 = 0; d0 < 4; ++d0) qf[d0] = *(const bf16x8*)(QD + row * 512 + h * 128 + 64 + d0 * 16 + hi * 8);
        attn_pass<4, false, false>(oacc, shm, qf, KD + (size_t)b * T * 512 + h * 128 + 64, 512, VDT + (size_t)(b * 4 + h) * 128 * T, T, 0, (q0 + 256) / 64,
                            0, qpos, 0, 0, qw0, qw0 + 31, 0ull, -lam, mf, ilf);
#pragma unroll
        for (int db = 0; db < 4; ++db)
#pragma unroll
            for (int r4 = 0; r4 < 4; ++r4) { const f32x4 v = o0s[(db * 4 + r4) * 64];
#pragma unroll
                for (int e = 0; e < 4; ++e) oacc[db][4 * r4 + e] += v[e]; }
    }
    { LAS unsigned char* stg = shm + OFF_IMP + wid * (32 * 272);
#pragma unroll
      for (int r = 0; r < 16; ++r) {
        float ss = 0.f;
#pragma unroll
        for (int db = 0; db < 4; ++db) ss += oacc[db][r] * oacc[db][r];
        ss += __shfl_xor(ss, 1); ss += __shfl_xor(ss, 2); ss += __shfl_xor(ss, 4); ss += __shfl_xor(ss, 8); ss += __shfl_xor(ss, 16);
        const float rn = rsqrtf(ss * (1.f / 128.f) + EPS) * outscale;
#pragma unroll
        for (int db = 0; db < 4; ++db) *(LAS bf16_t*)(stg + crow(r, hi) * 272 + (32 * db + r32) * 2) = f2bf(oacc[db][r] * rn);
      }
      asm volatile("s_waitcnt lgkmcnt(0)" ::: "memory");
      bf16_t* OA = oab_ptr(scratch) + ((size_t)b * T + qw0) * 512 + h * 128;
#pragma unroll
      for (int i = 0; i < 8; ++i) { const int rr = i * 4 + (lane >> 4), ch = lane & 15; const u32x4 v = *(const LAS u32x4*)(stg + rr * 272 + ch * 16); *(u32x4*)(OA + (size_t)rr * 512 + ch * 8) = v; }
    }
    __syncthreads();
}

__device__ __forceinline__ void nsa_unit(LAS unsigned char* shm, unsigned char* ws, float* dout, int b, int g, int cur) {
    const int tid = opaque_tid(), lane = tid & 63, wid = tid >> 6, r32 = lane & 31, hi = lane >> 5;
    const int q0 = cur * 64, head = g * 4 + (wid >> 1), qlw = 32 * (wid & 1), qloc = qlw + r32, qpos = q0 + qloc; const size_t row = (size_t)b * T + qpos;
    const int bg = b * 2 + g;
    LAS float* imp = (LAS float*)(shm + OFF_IMP);
    LAS unsigned long long* selm = (LAS unsigned long long*)(shm + OFF_SEL);
    bf16x8 qf[4];
    { const bf16_t* QN = (const bf16_t*)(ws + WS_QN);
#pragma unroll
      for (int d0 = 0; d0 < 4; ++d0) qf[d0] = *(const bf16x8*)(QN + row * 512 + head * 64 + d0 * 16 + hi * 8); }
    const float* gn = (const float*)(ws + WS_GN) + row * 24 + head * 3;
    f32x16 oacc[2];
    const bf16_t* KC = (const bf16_t*)(ws + WS_KC) + (size_t)bg * 256 * 64; const bf16_t* VCT = (const bf16_t*)(ws + WS_VCT) + (size_t)bg * 128 * 256;
    const int hic = min(254, (qpos - 31) >> 4), hic_min = min(254, (q0 + qlw - 31) >> 4), hic_max = min(254, (q0 + qlw + 31 - 31) >> 4);
    const int ntc = (min(254, (q0 + 63 - 31) >> 4) >> 6) + 1;
    float m_c, il_c;
    { f32x16 tc[4];
      attn_pass<4, false, false, true>(tc, shm, qf, KC, 64, VCT, 256, 0, ntc, 0, hic, 0, 0, hic_min, hic_max, 0ull, gn[0], m_c, il_c);
      oacc[0] = tc[0]; oacc[1] = tc[1];
      LAS float* ih = imp + (wid >> 1) * IMP_H + qlw;
#pragma unroll
      for (int jb = 0; jb < 2; ++jb)
#pragma unroll
          for (int r = 0; r < 16; ++r) ih[(32 * jb + r32) * 65 + crow(r, hi)] = tc[2 + jb][r];
    }
    __syncthreads();
#pragma unroll 1
    for (int qi = 0; qi < 8; ++qi) {
        const int q = wid * 8 + qi, j = lane;
        float v = ((imp[j * 65 + q] + imp[IMP_H + j * 65 + q]) + imp[2 * IMP_H + j * 65 + q]) + imp[3 * IMP_H + j * 65 + q];
        if (j > cur) v = 0.f; else if (j == 0 || j == cur || j == cur - 1) v = 1.0e4f; else v = fmaxf(v, 1e-30f);
        const unsigned key = (__float_as_uint(v) & ~63u) | (unsigned)(63 - j);
        unsigned thr = 0u;
#pragma unroll
        for (int bitp = 30; bitp >= 0; --bitp) { const unsigned cand = thr | (1u << bitp); const int cge = __popcll(__ballot(key >= cand)); thr = (cge >= 8) ? cand : thr; }
        const bool sel = key >= thr;
        const unsigned long long bits = __ballot(sel);
        if (lane == 0) selm[q] = bits;
    }
    __syncthreads();
    const unsigned long long selbits = selm[qloc];
    const bf16_t* KS = (const bf16_t*)(ws + WS_KS) + (size_t)b * T * 128 + g * 64; const bf16_t* VST = (const bf16_t*)(ws + WS_VST) + (size_t)bg * 64 * T;
    float mf, ilf;
    attn_pass<2, true, true>(oacc, shm, qf, KS, 128, VST, T, 0, cur + 1, 0, qpos, 0, 0, q0 + qlw, q0 + qlw + 31, selbits, gn[1], mf, ilf);
    const bf16_t* KW = (const bf16_t*)(ws + WS_KW) + (size_t)b * T * 128 + g * 64; const bf16_t* VWT = (const bf16_t*)(ws + WS_VWT) + (size_t)bg * 64 * T;
    attn_pass<2, false, true>(oacc, shm, qf, KW, 128, VWT, T, max(0, cur - 8), cur + 1, qpos - 511, qpos, q0 + qlw - 511, q0 + qlw + 31 - 511, q0 + qlw, q0 + qlw + 31, 0ull, gn[2], mf, ilf);
    { const int tid2 = opaque_tid(), lane2 = tid2 & 63, wid2 = tid2 >> 6, r32b = lane2 & 31, hib = lane2 >> 5;
      LAS unsigned char* stg = shm + wid2 * (32 * 144);
#pragma unroll
      for (int r = 0; r < 16; ++r) { LAS bf16_t* p = (LAS bf16_t*)(stg + crow(r, hib) * 144 + r32b * 2); p[0] = f2bf(oacc[0][r]); p[32] = f2bf(oacc[1][r]); }
      asm volatile("s_waitcnt lgkmcnt(0)" ::: "memory");
      bf16_t* OB = oab_ptr(dout) + (size_t)M * 512 + ((size_t)b * T + cur * 64 + 32 * (wid2 & 1)) * 512 + (g * 4 + (wid2 >> 1)) * 64;
#pragma unroll
      for (int i = 0; i < 4; ++i) { const int rr = i * 8 + (lane2 >> 3), ch = lane2 & 7; const u32x4 v = *(const LAS u32x4*)(stg + rr * 144 + ch * 16); *(u32x4*)(OB + (size_t)rr * 512 + ch * 8) = v; } }
    __syncthreads();
}
}

struct Params { const float* in[18]; float* out; unsigned char* ws; int ph_lo, ph_hi; };
enum { I_X = 0, I_POS, I_F1N, I_F1GU, I_F1D, I_MIXN, I_WIN, I_LAM, I_CPOS, I_CW1, I_CW2, I_WA, I_WB, I_WO, I_F2N, I_F2GU, I_F2D, I_FINN };

__device__ __forceinline__ int headperm(int p) { return p < 16 ? (p >> 1) + 8 * (p & 1) : p; }
__device__ __forceinline__ int mapcol(int kind, int n) {
    if (kind == 0) return n;
    if (kind == 1) { const int tile = n >> 8, w = n & 255; return w < 128 ? tile * 128 + w : FF + tile * 128 + (w - 128); }
    if (kind == 3) return (n & ~63) + headperm(n & 63);
    if (n < 2816) {
        const bool ropeseg = (n < 1024) || (n >= 1536 && n < 2048) || (n >= 2304 && n < 2432) || (n >= 2560 && n < 2688);
        return ropeseg ? (n & ~63) + headperm(n & 63) : n;
    }
    if (n < 3840) return 2840 + (n - 2816);
    if (n < 4864) return 3864 + (n - 3840);
    if (n < 4888) return 2816 + (n - 4864);
    return -1;
}
__device__ __forceinline__ void transpose_item(const float* __restrict__ W, int K, int N, bf16_t* __restrict__ WT, int nblk, int item, int kind, const float* __restrict__ gain, LAS float* scr, int lane) {
    const int kb = item / nblk, nb = item % nblk, k0 = 64 * kb, n0 = 32 * nb;
    const int lc = mapcol(kind, n0 + (lane & 31));
    float wv[32];
    const float* wp = W + (size_t)(k0 + (lane >> 5)) * N + (lc >= 0 ? lc : 0);
#pragma unroll
    for (int i = 0; i < 32; ++i) wv[i] = wp[(size_t)(2 * i) * N];
#pragma unroll
    for (int i = 0; i < 32; ++i) { const int kk = 2 * i + (lane >> 5); float v = lc >= 0 ? wv[i] : 0.f; if (gain) v *= gain[k0 + kk]; scr[kk * 33 + (lane & 31)] = v; }
    asm volatile("s_waitcnt lgkmcnt(0)" ::: "memory");
    const int c = lane & 7;
#pragma unroll
    for (int j = 0; j < 4; ++j) { const int n = (lane >> 3) + 8 * j; const LAS float* s = scr + (8 * c) * 33 + n;
        u32x4 o; o.x = cvtpk(s[0 * 33], s[1 * 33]); o.y = cvtpk(s[2 * 33], s[3 * 33]); o.z = cvtpk(s[4 * 33], s[5 * 33]); o.w = cvtpk(s[6 * 33], s[7 * 33]);
        *(u32x4*)(WT + (size_t)(n0 + n) * K + k0 + 8 * c) = o; }
    asm volatile("s_waitcnt lgkmcnt(0)" ::: "memory");
}
__device__ __forceinline__ float wave_sum(float v) {
#pragma unroll
    for (int o = 1; o < 64; o <<= 1) v += my_shfl_xor(v, o);
    return v;
}
__device__ __forceinline__ void prep_phase(const Params& P, LAS unsigned char* lds) {
    const int tid = opaque_tid(), lane = tid & 63, wave = tid >> 6;
    const int gw = blockIdx.x * 8 + wave, NGW = gridDim.x * 8;
    LAS float* scr = (LAS float*)(lds + wave * 16384);
    unsigned char* ws = P.ws;
    constexpr int JOBS = 12;
    constexpr int ITEMS[JOBS] = {16 * 176, 44 * 32, 16 * 176, 44 * 32, 16 * 160, 32 * 8, 32 * 8, 4 * 2, 4 * 2, 8 * 32, 8 * 32, 16 * 32};
    constexpr int PER_LAYER = 16 * 176 * 2 + 44 * 32 * 2 + 16 * 160 + 32 * 8 * 2 + 4 * 2 * 2 + 8 * 32 * 2 + 16 * 32;
    for (int it = gw; it < NL * PER_LAYER; it += NGW) {
        const int l = it / PER_LAYER; int r = it % PER_LAYER, job = 0;
#pragma unroll
        for (int jj = 0; jj < JOBS - 1; ++jj) { if (job == jj && r >= ITEMS[jj]) { r -= ITEMS[jj]; job = jj + 1; } }
        unsigned char* wl = ws + WS_W + (size_t)l * W_LAYER;
        const float* src; bf16_t* dst; int K, N, nblk, kind = 0; const float* gain = nullptr;
        switch (job) {
            case 0:  src = P.in[I_F1GU] + (size_t)l * D * 2 * FF; dst = (bf16_t*)(wl + WO_GU1); K = D; N = 2 * FF; nblk = 176; kind = 1; gain = P.in[I_F1N] + l * D; break;
            case 1:  src = P.in[I_F1D] + (size_t)l * FF * D; dst = (bf16_t*)(wl + WO_D1); K = FF; N = D; nblk = 32; break;
            case 2:  src = P.in[I_F2GU] + (size_t)l * D * 2 * FF; dst = (bf16_t*)(wl + WO_GU2); K = D; N = 2 * FF; nblk = 176; kind = 1; gain = P.in[I_F2N] + l * D; break;
            case 3:  src = P.in[I_F2D] + (size_t)l * FF * D; dst = (bf16_t*)(wl + WO_D2); K = FF; N = D; nblk = 32; break;
            case 4:  src = P.in[I_WIN] + (size_t)l * D * 4888; dst = (bf16_t*)(wl + WO_IN); K = D; N = 4888; nblk = 160; kind = 2; gain = P.in[I_MIXN] + l * D; break;
            case 5:  src = P.in[I_CW1] + (size_t)(l * 2 + 0) * 2048 * 256; dst = (bf16_t*)(wl + WO_C1); K = 2048; N = 256; nblk = 8; break;
            case 6:  src = P.in[I_CW1] + (size_t)(l * 2 + 1) * 2048 * 256; dst = (bf16_t*)(wl + WO_C1) + 256 * 2048; K = 2048; N = 256; nblk = 8; break;
            case 7:  src = P.in[I_CW2] + (size_t)(l * 2 + 0) * 256 * 64; dst = (bf16_t*)(wl + WO_C2); K = 256; N = 64; nblk = 2; kind = 3; break;
            case 8:  src = P.in[I_CW2] + (size_t)(l * 2 + 1) * 256 * 64; dst = (bf16_t*)(wl + WO_C2) + 64 * 256; K = 256; N = 64; nblk = 2; break;
            case 9:  src = P.in[I_WA] + (size_t)l * 512 * D; dst = (bf16_t*)(wl + WO_A); K = 512; N = D; nblk = 32; break;
            case 10: src = P.in[I_WB] + (size_t)l * 512 * D; dst = (bf16_t*)(wl + WO_B); K = 512; N = D; nblk = 32; break;
            default: src = P.in[I_WO] + (size_t)l * D * D; dst = (bf16_t*)(wl + WO_O); K = D; N = D; nblk = 32; break;
        }
        transpose_item(src, K, N, dst, nblk, r, kind, gain, scr, lane);
    }
    { const float* x = P.in[I_X]; bf16_t* HB = (bf16_t*)(ws + WS_HB); float* ssq0 = (float*)(ws + WS_SSQ);
      for (int m0 = gw * 2; m0 < M; m0 += NGW * 2) {
        f32x4 v[2][4];
#pragma unroll
        for (int rr = 0; rr < 2; ++rr) { const f32x4* xr = (const f32x4*)(x + (size_t)(m0 + rr) * D) + lane;
#pragma unroll
            for (int j = 0; j < 4; ++j) v[rr][j] = xr[64 * j]; }
#pragma unroll
        for (int rr = 0; rr < 2; ++rr) { const int m = m0 + rr;
            unsigned long long* o8 = (unsigned long long*)(HB + (size_t)m * D) + lane; float s = 0.f;
#pragma unroll
            for (int j = 0; j < 4; ++j) { const f32x4 w = v[rr][j]; s += (w[0] * w[0] + w[1] * w[1]) + (w[2] * w[2] + w[3] * w[3]);
                o8[64 * j] = (unsigned long long)cvtpk(w[0], w[1]) | ((unsigned long long)cvtpk(w[2], w[3]) << 32); }
            s = wave_sum(s); if (lane < 16) ssq0[(size_t)m * 16 + lane] = (lane == 0) ? s : 0.f; }
      } }
    { const int* pos = (const int*)P.in[I_POS]; float* rope = (float*)(ws + WS_ROPE);
      const float inv[8] = {1.0f, 0.1939227432012558f, 0.03760603070259094f, 0.007292664609849453f, 0.0014142135623842478f, 0.00027424818836152554f, 5.318296098266728e-05f, 1.0313386155758053e-05f};
      for (int i = blockIdx.x * 512 + tid; i < M * 8; i += gridDim.x * 512) {
        const int m = i >> 3, d = i & 7; float iv = inv[0];
#pragma unroll
        for (int k = 1; k < 8; ++k) iv = (d == k) ? inv[k] : iv;
        const float ang = (float)pos[m] * iv; float sv, cv; sincosf(ang, &sv, &cv);
        rope[(size_t)m * 16 + d] = cv; rope[(size_t)m * 16 + 8 + d] = sv;
      } }
    { bf16_t* vct = (bf16_t*)(ws + WS_VCT);
      for (int i = blockIdx.x * 512 + tid; i < 16 * 64 * 256; i += gridDim.x * 512) {
        const int c = i & 255, j = (i >> 8) & 63, bgi = i >> 14;
        const float ov = (c >= 4 * j && c <= 4 * j + 2) ? 1.f : ((c == 4 * j + 3 || c == 4 * j - 1) ? 0.5f : 0.f);
        vct[((size_t)bgi * 128 + 64 + j) * 256 + swap23(c)] = f2bf(c == 255 ? 0.f : ov);
      } }
    { float* cb = (float*)(ws + WS_CBP);
      for (int it = gw; it < NL * 2 * 4 * 32; it += NGW) {
        const int kc = it & 31, nbk = (it >> 5) & 3, lk = it >> 7;
        const float* w1 = P.in[I_CW1] + (size_t)lk * 2048 * 256; const float* cp = P.in[I_CPOS] + (size_t)lk * 2048; const int n = nbk * 64 + lane;
        float s = 0.f;
#pragma unroll 8
        for (int k = kc * 64; k < kc * 64 + 64; ++k) s += cp[k] * w1[(size_t)k * 256 + n];
        cb[((size_t)lk * 32 + kc) * 256 + n] = s;
      } }
}
__device__ __forceinline__ void final_phase(const Params& P) {
    const int tid_ = opaque_tid(), lane = tid_ & 63, gw = blockIdx.x * 8 + (tid_ >> 6), NGW = gridDim.x * 8;
    const float* ssq = (const float*)(P.ws + WS_SSQ); const bf16_t* HB = (const bf16_t*)(P.ws + WS_HB);
    const float* gp = P.in[I_FINN] + lane * 8;
    const f32x4 g0 = *(const f32x4*)gp, g1 = *(const f32x4*)(gp + 4), g2 = *(const f32x4*)(gp + 512), g3 = *(const f32x4*)(gp + 516);
    for (int m0 = gw * 4; m0 < M; m0 += NGW * 4) {
        u32x4 v[4][2]; float rs[4];
#pragma unroll
        for (int rr = 0; rr < 4; ++rr) { rs[rr] = rowscale(ssq, m0 + rr); const bf16_t* hr = HB + (size_t)(m0 + rr) * D + lane * 8; v[rr][0] = *(const u32x4*)hr; v[rr][1] = *(const u32x4*)(hr + 512); }
#pragma unroll
        for (int rr = 0; rr < 4; ++rr) { float* o = P.out + (size_t)(m0 + rr) * D + lane * 8; const float r = rs[rr];
            const u32x4 a = v[rr][0], b = v[rr][1];
            *(f32x4*)o = (f32x4){bflo(a.x), bfhi(a.x), bflo(a.y), bfhi(a.y)} * r * g0; *(f32x4*)(o + 4) = (f32x4){bflo(a.z), bfhi(a.z), bflo(a.w), bfhi(a.w)} * r * g1;
            *(f32x4*)(o + 512) = (f32x4){bflo(b.x), bfhi(b.x), bflo(b.y), bfhi(b.y)} * r * g2; *(f32x4*)(o + 516) = (f32x4){bflo(b.z), bfhi(b.z), bflo(b.w), bfhi(b.w)} * r * g3; }
    }
}

#define XB_TMO      128
#define XB_XCNT(j)  (256  + 64 * (j))
#define XB_XSUB(j)  (1280 + 64 * (j))
#define XB_XGEN(j)  (2304 + 64 * (j))
#define XB_TOP      3328
#define XB_TOPGEN   3392
#define XCD_BAR_WORDS 3456
#define XB_SPIN_CAP (1u << 18)

__device__ __forceinline__ unsigned xb_ld(unsigned* p)              { return __hip_atomic_load(p, __ATOMIC_RELAXED, __HIP_MEMORY_SCOPE_AGENT); }
__device__ __forceinline__ unsigned xb_add(unsigned* p, unsigned v) { return __hip_atomic_fetch_add(p, v, __ATOMIC_RELAXED, __HIP_MEMORY_SCOPE_AGENT); }
__device__ __forceinline__ unsigned xb_xcc_id() { return (unsigned)__builtin_amdgcn_s_getreg((3 << 11) | 20) & 0xFu; }
#define XB_SPIN(cond, bar) do { unsigned _sp = 0; while (cond) { __builtin_amdgcn_s_sleep(1); \
    if ((++_sp & 255u) == 0u) { if (xb_ld(&(bar)[XB_TMO])) break; if (_sp > XB_SPIN_CAP) { atomicAdd(&(bar)[XB_TMO], 1u); break; } } } } while (0)

struct XcdBarrier {
    unsigned* bar; unsigned x;
    volatile LAS unsigned* st;
};

__device__ __forceinline__ XcdBarrier xcd_barrier_post(unsigned* bar, volatile LAS unsigned* st) {
    XcdBarrier b; b.bar = bar; b.x = xb_xcc_id(); b.st = st;
    if (threadIdx.x == 0) (void)xb_add(&bar[XB_XCNT(b.x)], 1u);
    return b;
}
__device__ __forceinline__ void xcd_barrier_complete(unsigned* bar, unsigned x, unsigned& nloc, unsigned& nx) {
    const unsigned G = gridDim.x * gridDim.y * gridDim.z;
    unsigned sum, cnt, mine, sp = 0u;
    for (;;) {
        sum = 0u; cnt = 0u; mine = 0u;
#pragma unroll
        for (unsigned j = 0; j < 16; ++j) { const unsigned c = xb_ld(&bar[XB_XCNT(j)]); sum += c; cnt += (c > 0u) ? 1u : 0u; mine = (j == x) ? c : mine; }
        if (sum == G) break;
        __builtin_amdgcn_s_sleep(1);
        if ((++sp & 255u) == 0u) { if (xb_ld(&bar[XB_TMO])) break; if (sp > XB_SPIN_CAP) { atomicAdd(&bar[XB_TMO], 1u); break; } }
    }
    nloc = mine > 0u ? mine : 1u; nx = cnt > 0u ? cnt : 1u;
}

__device__ __forceinline__ void xcd_barrier(const XcdBarrier& b) {
    asm volatile("s_waitcnt vmcnt(0)" ::: "memory");
    __syncthreads();
    if (threadIdx.x == 0) {
        unsigned* bar = b.bar;
        __builtin_amdgcn_s_waitcnt(0);
        unsigned nloc = b.st[0], nx = b.st[1];
        if (nloc == 0u) { xcd_barrier_complete(bar, b.x, nloc, nx); b.st[0] = nloc; b.st[1] = nx; }
        const unsigned old = xb_add(&bar[XB_XSUB(b.x)], 1u);
        const unsigned gen = old / nloc;
        if (old + 1u == (gen + 1u) * nloc) {
            __builtin_amdgcn_fence(__ATOMIC_RELEASE, "agent");
            asm volatile("s_waitcnt vmcnt(0)" ::: "memory");
            const unsigned og = xb_add(&bar[XB_TOP], 1u);
            const unsigned tg = og / nx;
            if (og + 1u == (tg + 1u) * nx) xb_add(&bar[XB_TOPGEN], 1u);
            else XB_SPIN(xb_ld(&bar[XB_TOPGEN]) == tg, bar);
            __builtin_amdgcn_fence(__ATOMIC_ACQUIRE, "agent");
            xb_add(&bar[XB_XGEN(b.x)], 1u);
            asm volatile("s_waitcnt vmcnt(0)" ::: "memory");
        } else {
            XB_SPIN(xb_ld(&bar[XB_XGEN(b.x)]) == gen, bar);
            __builtin_amdgcn_fence(__ATOMIC_ACQUIRE, "agent");
            asm volatile("s_waitcnt vmcnt(0)" ::: "memory");
        }
    }
    __syncthreads();
}

constexpr int N_PHASES = 22;
#ifndef REP_PREP
#define REP_PREP 1
#endif
#ifndef REP_CMP
#define REP_CMP 1
#endif
#ifndef REP_DIFF
#define REP_DIFF 1
#endif
#ifndef REP_NSA
#define REP_NSA 1
#endif
#ifndef REP_GU
#define REP_GU 1
#endif
#ifndef REP_IN
#define REP_IN 1
#endif
template <class Epi, class Sched> __device__ __forceinline__ void run_gemm(LAS unsigned char* lds, const pg8::Gemm& g, const Sched& S, const Epi& E) {
    pg8::gemm_phase<Epi, Sched, !Epi::AFTER_DRAIN, true>(lds, g, S, E);
}
__global__ void __launch_bounds__(512, 2) mk_fwd(Params P) {
    extern __shared__ __attribute__((aligned(16))) unsigned char lds_raw[];
    LAS unsigned char* lds = (LAS unsigned char*)lds_raw;
    cg::grid_group grid = cg::this_grid();
    volatile LAS unsigned* bst = (volatile LAS unsigned*)(lds + LDS_BYTES - 64);
    if (threadIdx.x < 2) bst[threadIdx.x] = 0u;
    __syncthreads();
    XcdBarrier xbar = xcd_barrier_post((unsigned*)(P.ws + WS_BAR), bst);
    if (P.ph_hi - P.ph_lo > 1) grid.sync();
    unsigned char* ws = P.ws; const int G = gridDim.x, bx = blockIdx.x;
    const int vcu = (G % 8 == 0) ? (bx % 8) * (G / 8) + bx / 8 : bx;
    float* ssq = (float*)(ws + WS_SSQ);
    for (int ph = P.ph_lo; ph < P.ph_hi; ++ph) {
        if (ph >= 1 && ph < N_PHASES - 1 && (ph - 1) % 10 == 3) continue;
        if (ph > P.ph_lo) xcd_barrier(xbar);
        if (ph == 0) { for (int rep_ = 0; rep_ < REP_PREP; ++rep_) prep_phase(P, lds); continue; }
        if (ph == N_PHASES - 1) { final_phase(P); continue; }
        const int l = (ph - 1) / 10, k = (ph - 1) % 10;
        unsigned char* wl = ws + WS_W + (size_t)l * W_LAYER;
        const bf16_t* HB = (const bf16_t*)(ws + WS_HB);
        if (k == 0 || k == 8) {
            pg8::Gemm g{HB, (const bf16_t*)(wl + (k == 0 ? WO_GU1 : WO_GU2)), M, 2 * FF, D, D, D};
            pg8::StaticOrder S; S.init(M, 2 * FF, G, bx);
            fill_rs(lds, S, ssq);
            EpiGU E{(bf16_t*)(ws + WS_ACT), ssq, (const LAS float*)(lds + RS_OFF)};
            for (int rep_ = 1; rep_ < REP_GU; ++rep_) run_gemm(lds, g, S, E);
            run_gemm(lds, g, S, E);
        } else if (k == 1 || k == 7 || k == 9) {
            const bool isout = (k == 7);
            if (k == 1 && bx == G - 1) {
                const int t_ = opaque_tid(); const float* cbp = (const float*)(ws + WS_CBP) + ((size_t)(l * 2 + (t_ >> 8)) * 32) * 256 + (t_ & 255); float s_ = 0.f;
                for (int kc = 0; kc < 32; ++kc) s_ += cbp[kc * 256];
                ((float*)(ws + WS_CBIAS))[l * 512 + t_] = s_;
            }
            pg8::Gemm g{(const bf16_t*)(ws + (isout ? WS_Y : WS_ACT)), (const bf16_t*)(wl + (k == 1 ? WO_D1 : k == 7 ? WO_O : WO_D2)), M, D, isout ? D : FF, isout ? D : FF, isout ? D : FF};
            pg8::StaticOrder S; S.init(M, D, G, bx);
            EpiRes E{(const float*)nullptr, (bf16_t*)(ws + WS_HB), ssq, isout ? 1.f : 0.5f};
            run_gemm(lds, g, S, E);
        } else if (k == 2) {
            pg8::Gemm g{HB, (const bf16_t*)(wl + WO_IN), M, NIN, D, D, D};
            pg8::StaticOrder S; S.init(M, NIN, G, bx);
            fill_rs(lds, S, ssq);
            EpiIn E{ssq, (const float*)(ws + WS_ROPE), ws, (const LAS float*)(lds + RS_OFF)};
            for (int rep_ = 1; rep_ < REP_IN; ++rep_) run_gemm(lds, g, S, E);
            run_gemm(lds, g, S, E);
        } else if (k == 4) {
            const float* lp = P.in[I_LAM] + l * 256; const int lane = opaque_tid() & 63;
            const float s1 = wave_sum(lp[lane] * lp[64 + lane]), s2 = wave_sum(lp[128 + lane] * lp[192 + lane]);
            const float lam_init = 0.8f - 0.6f * expf(-0.3f * (float)l);
            const float lam = expf(s1) - expf(s2) + lam_init;
            for (int p = vcu; p < 256; p += G) {
                const int bh = p >> 3, i = p & 7;
                if (i == 0) {
                    pg8::Gemm g{(const bf16_t*)(ws + WS_KCR), (const bf16_t*)(wl + WO_C1), 8192, 512, 2048, 1024, 2048};
                    CmpOrder S{1 << 20, bh};
                    EpiCmp E{(const float*)(ws + WS_CBIAS) + l * 512, (const bf16_t*)(wl + WO_C2), (bf16_t*)(ws + WS_KC), (bf16_t*)(ws + WS_VCT)};
                    run_gemm(lds, g, S, E);
                }
                if ((opaque_tid() >> 6) < 4) __builtin_amdgcn_s_setprio(2);
                const int nu = (i == 0) ? 1 : (i == 7) ? 3 : 2;
#pragma unroll 1
                for (int uu = 0; uu < nu; ++uu) {
                    const int qb = (i == 0) ? 14 : (i == 7) ? (uu == 0 ? 8 : uu == 1 ? 7 : 0) : (uu == 0 ? (i == 1 ? 15 : 15 - i) : i);
                    att::diff_unit(lds, ws, P.out, bh >> 2, bh & 3, qb, lam, 1.f - lam_init);
                }
                __builtin_amdgcn_s_setprio(0);
            }
        } else if (k == 5) {
            if ((opaque_tid() >> 6) < 4) __builtin_amdgcn_s_setprio(2);
            for (int rep_ = 0; rep_ < REP_NSA; ++rep_)
            for (int p = vcu; p < 256; p += G) {
                const int bg = p >> 4, i = p & 15;
#pragma unroll 1
                for (int uu = 0; uu < 4; ++uu) { const int cur = (uu == 0) ? 63 - i : (uu == 1) ? 32 + i : (uu == 2) ? 31 - i : i; att::nsa_unit(lds, ws, P.out, bg >> 1, bg & 1, cur); }
            }
            __builtin_amdgcn_s_setprio(0);
        } else {
            BrOrder S; S.S0.init(M, D, G, bx);
            pg8::Gemm g{(const bf16_t*)oab_ptr(P.out), (const bf16_t*)(wl + WO_A), 2 * M, 2 * D, 512, 512, 512};
            EpiBr E{EpiBrA{(bf16_t*)(ws + WS_Y), (const bf16_t*)(ws + WS_GA)}, EpiBrB{(bf16_t*)(ws + WS_Y), (const bf16_t*)(ws + WS_GB)}};
            run_gemm(lds, g, S, E);
        }
    }
}

extern "C" void kernel_launch(void* const* d_in, const int* in_sizes, int n_in, void* d_out, int out_size, void* d_ws, size_t ws_size, hipStream_t stream) {
    static int grid = 0;
    if (grid == 0) {
        if (n_in != 18 || out_size != M * D || ws_size < WS_END) { fprintf(stderr, "kernel_launch: unexpected shapes (n_in %d out %d ws %zu)\n", n_in, out_size, ws_size); grid = -1; return; }
        int dev = 0, cus = 0, per_cu = 0;
        (void)hipGetDevice(&dev); (void)hipDeviceGetAttribute(&cus, hipDeviceAttributeMultiprocessorCount, dev);
        (void)hipFuncSetAttribute((const void*)mk_fwd, hipFuncAttributeMaxDynamicSharedMemorySize, LDS_BYTES);
        (void)hipOccupancyMaxActiveBlocksPerMultiprocessor(&per_cu, (const void*)mk_fwd, 512, LDS_BYTES);
        if (per_cu < 1) per_cu = 1;
        grid = cus * per_cu; if (grid > 256) grid = 256; if (grid < 32) grid = 32;
        (void)hipGetLastError();
    }
    if (grid < 0) return;
    (void)hipMemsetAsync((char*)d_ws + WS_BAR, 0, 16384, stream);
    Params p{};
    for (int i = 0; i < 18; ++i) p.in[i] = (const float*)d_in[i];
    p.out = (float*)d_out; p.ws = (unsigned char*)d_ws;
#if MK_MULTI
    for (int ph = 0; ph < N_PHASES; ++ph) { p.ph_lo = ph; p.ph_hi = ph + 1; hipLaunchKernelGGL(mk_fwd, dim3(grid), dim3(512), LDS_BYTES, stream, p); }
#else
    p.ph_lo = 0; p.ph_hi = N_PHASES;
    void* args[] = {&p};
    hipError_t e = hipLaunchCooperativeKernel((const void*)mk_fwd, dim3(grid), dim3(512), args, LDS_BYTES, stream);
    if (e != hipSuccess) fprintf(stderr, "cooperative launch failed: %s (grid %d)\n", hipGetErrorString(e), grid);
#endif
}
```
